# Optimizing an MI355X kernel written in HIP

```python
import math
import jax
import jax.numpy as jnp
from jax import lax
import numpy as np

D_MODEL = 2048
BATCH = 8
SEQ = 2048
DEPTH = 2
DEC_BATCH = 8
DEC_SEQ = 4096
PAST_LEN = 128

PLE_DIM = 256
GRID_W = 64
A_HEADS = 8
A_QK_DIM = 64
A_V_DIM = 2 * A_QK_DIM
A_WIDTH = A_HEADS * A_V_DIM
Q_BLOCK = 128
T5_BUCKETS = 32
T5_MAX_DIST = 128
B_HEADS = 8
B_HEAD_DIM = 128
B_WIDTH = B_HEADS * B_HEAD_DIM
NA_ROWS = 8
NA_COLS = 16
AB_IN = 3 * A_WIDTH + 3 * B_WIDTH
AB_OUT = A_WIDTH + B_WIDTH
C_WIDTH = D_MODEL
SHORT_CONV = 3
FILTER_EMB = 33
FILTER_HIDDEN = 64
FILTER_TARGET = 1e-2
FAST_DECAY_PCT = 0.3
SLOW_DECAY_PCT = 1.5
D_FF = ((8 * D_MODEL + 3 * 256 - 1) // (3 * 256)) * 256
N_EVEN = (DEPTH + 1) // 2
N_ODD = DEPTH // 2
EPS = 1e-6

kernel_name = "hybrid_diffattn_natten_hyena_encoder"


def rms_norm(x, g):
    xf = x.astype(jnp.float32)
    y = xf * lax.rsqrt(jnp.mean(xf * xf, axis=-1, keepdims=True) + EPS)
    return (y * g.astype(jnp.float32)).astype(x.dtype)


def t5_bucket(rel):
    nb = T5_BUCKETS // 2
    max_exact = nb // 2
    ret = jnp.where(rel > 0, nb, 0)
    n = jnp.abs(rel)
    nf = jnp.maximum(n, 1).astype(jnp.float32)
    large = max_exact + (jnp.log(nf / max_exact) / math.log(T5_MAX_DIST / max_exact)
                         * (nb - max_exact)).astype(jnp.int32)
    large = jnp.minimum(large, nb - 1)
    return ret + jnp.where(n < max_exact, n, large)


def diff_attention(q1, q2, k1, k2, v, lam, rel_table):
    B, L, H, dk = q1.shape
    scale = dk ** -0.5
    n_blk = L // Q_BLOCK
    kpos = jnp.arange(L, dtype=jnp.int32)

    def block(i):
        qs = i * Q_BLOCK
        q1b = lax.dynamic_slice_in_dim(q1, qs, Q_BLOCK, axis=1)
        q2b = lax.dynamic_slice_in_dim(q2, qs, Q_BLOCK, axis=1)
        qpos = qs + jnp.arange(Q_BLOCK, dtype=jnp.int32)
        bias = rel_table[t5_bucket(kpos[None, :] - qpos[:, None])]
        bias = jnp.transpose(bias, (2, 0, 1)).astype(jnp.float32)
        s1 = jnp.einsum('bqhd,bkhd->bhqk', q1b, k1).astype(jnp.float32) * scale + bias
        s2 = jnp.einsum('bqhd,bkhd->bhqk', q2b, k2).astype(jnp.float32) * scale + bias
        a = jax.nn.softmax(s1, axis=-1) - lam * jax.nn.softmax(s2, axis=-1)
        return jnp.einsum('bhqk,bkhd->bqhd', a.astype(v.dtype), v)

    out = lax.map(block, jnp.arange(n_blk, dtype=jnp.int32))
    return jnp.transpose(out, (1, 0, 2, 3, 4)).reshape(B, L, H, v.shape[-1])


def neighbourhood_attention(q, k, v, na_table):
    B, L, H, d = q.shape
    rows = L // GRID_W
    kh = min(NA_ROWS, rows)
    kw = NA_COLS
    n_keys = kh * kw
    scale = d ** -0.5
    cols = jnp.arange(GRID_W, dtype=jnp.int32)
    c_start = jnp.clip(cols - kw // 2, 0, GRID_W - kw)
    key_cols = c_start[:, None] + jnp.arange(kw, dtype=jnp.int32)
    dc = key_cols - cols[:, None] + (NA_COLS - 1)
    qg = jnp.transpose(q.reshape(B, rows, GRID_W, H, d), (1, 0, 2, 3, 4))

    def row_block(args):
        r, q_row = args
        r_start = jnp.clip(r - kh // 2, 0, rows - kh)
        key_rows = r_start + jnp.arange(kh, dtype=jnp.int32)
        idx = (key_rows[None, :, None] * GRID_W + key_cols[:, None, :]).reshape(GRID_W, n_keys)
        kb = jnp.take(k, idx, axis=1)
        vb = jnp.take(v, idx, axis=1)
        dr = key_rows - r + (NA_ROWS - 1)
        bias = na_table[:, dr[None, :, None], dc[:, None, :]]
        bias = bias.reshape(H, GRID_W, n_keys).astype(jnp.float32)
        s = jnp.einsum('bwhd,bwkhd->bhwk', q_row, kb).astype(jnp.float32) * scale + bias
        p = jax.nn.softmax(s, axis=-1)
        return jnp.einsum('bhwk,bwkhd->bwhd', p.astype(v.dtype), vb)

    out = lax.map(row_block, (jnp.arange(rows, dtype=jnp.int32), qg))
    return jnp.transpose(out, (1, 0, 2, 3, 4)).reshape(B, L, H, d)


def even_mixer(u, w_in, w_out, lam_vec, subln_g, na_table, rel_table, layer_idx):
    B, L, _ = u.shape
    z = u @ w_in
    qa, ka, va, qb, kb, vb = jnp.split(z, 6, axis=-1)
    qa = qa.reshape(B, L, A_HEADS, 2, A_QK_DIM)
    ka = ka.reshape(B, L, A_HEADS, 2, A_QK_DIM)
    va = va.reshape(B, L, A_HEADS, A_V_DIM)
    lam_init = 0.8 - 0.6 * math.exp(-0.3 * layer_idx)
    lv = lam_vec.astype(jnp.float32)
    lam = jnp.exp(jnp.sum(lv[0] * lv[1])) - jnp.exp(jnp.sum(lv[2] * lv[3])) + lam_init
    oa = diff_attention(qa[..., 0, :], qa[..., 1, :], ka[..., 0, :], ka[..., 1, :], va, lam, rel_table)
    oa = (rms_norm(oa, subln_g) * (1.0 - lam_init)).reshape(B, L, A_WIDTH)
    ob = neighbourhood_attention(qb.reshape(B, L, B_HEADS, B_HEAD_DIM),
                                 kb.reshape(B, L, B_HEADS, B_HEAD_DIM),
                                 vb.reshape(B, L, B_HEADS, B_HEAD_DIM), na_table)
    ob = ob.reshape(B, L, B_WIDTH)
    return jnp.concatenate([oa, ob], axis=-1) @ w_out


def hyena_filter(L, w1, b1, freq, w2, b2, w3):
    t = jnp.linspace(0.0, 1.0, L, dtype=jnp.float32)[:, None]
    bands = (FILTER_EMB - 1) // 2
    w = 2.0 * math.pi * jnp.arange(L, dtype=jnp.float32) / L
    f = jnp.linspace(1e-4, bands - 1, bands, dtype=jnp.float32)
    ang = w[:, None] * f[None, :]
    feats = jnp.concatenate([t, jnp.cos(ang), -jnp.sin(ang)], axis=-1)
    hdn = jnp.sin(freq[0] * (feats @ w1 + b1))
    hdn = jnp.sin(freq[1] * (hdn @ w2 + b2))
    h = (hdn @ w3).astype(jnp.float32)
    min_decay = math.log(FILTER_TARGET) / FAST_DECAY_PCT
    max_decay = math.log(FILTER_TARGET) / SLOW_DECAY_PCT
    deltas = jnp.abs(jnp.linspace(min_decay, max_decay, C_WIDTH, dtype=jnp.float32))
    decay = jnp.exp(-t * deltas[None, :])
    h_fwd = h[:, :C_WIDTH] * decay
    h_bwd = h[:, C_WIDTH:] * decay
    zero = jnp.zeros((1, C_WIDTH), jnp.float32)
    return jnp.concatenate([h_fwd, zero, h_bwd[:0:-1]], axis=0)


def hyena_mixer(u, w_in, conv_w, conv_b, w1, b1, freq, w2, b2, w3, skip, w_out):
    B, L, _ = u.shape
    z = u @ w_in
    zp = jnp.pad(z, ((0, 0), (1, 1), (0, 0)))
    z = zp[:, :-2] * conv_w[0] + zp[:, 1:-1] * conv_w[1] + zp[:, 2:] * conv_w[2] + conv_b
    x0, x1, v = jnp.split(z, 3, axis=-1)
    v = v * x1
    h = hyena_filter(L, w1, b1, freq, w2, b2, w3)
    V = jnp.fft.rfft(v.astype(jnp.float32), n=2 * L, axis=1)
    Hf = jnp.fft.rfft(h, axis=0)
    y = jnp.fft.irfft(V * Hf[None], n=2 * L, axis=1)[:, :L].astype(u.dtype)
    y = (y + v * skip) * x0
    return y @ w_out


def swiglu(u, w_in, w_out):
    g, up = jnp.split(u @ w_in, 2, axis=-1)
    return (jax.nn.silu(g) * up) @ w_out


def trunk(x, p, W):
    h = x
    for i in range(DEPTH):
        j = i // 2
        hn = rms_norm(h, W['norm_mix'][i])
        if i % 2 == 0:
            mix = even_mixer(hn, W['ab_w_in'][j], W['ab_w_out'][j], W['diff_lambda'][j],
                             W['diff_subln'][j], W['na_bias'][j], W['rel_bias_table'], i)
        else:
            mix = hyena_mixer(hn, W['c_w_in'][j], W['c_conv_w'][j], W['c_conv_b'][j],
                              W['c_filt_w1'][j], W['c_filt_b1'][j], W['c_filt_freq'][j],
                              W['c_filt_w2'][j], W['c_filt_b2'][j], W['c_filt_w3'][j],
                              W['c_skip'][j], W['c_w_out'][j])
        h = h + mix
        h = h + swiglu(rms_norm(h, W['norm_ffn'][i]), W['ffn_w_in'][i], W['ffn_w_out'][i])
        gate = jax.nn.sigmoid(rms_norm(h, W['norm_ple'][i]) @ W['ple_w_gate'][i])
        h = h + (p[i] @ W['ple_w_proj'][i]) * gate
    return rms_norm(h, W['final_norm'])


def setup_inputs(seed: int = 0) -> dict:
    key = jax.random.key(seed)
    keys = iter(jax.random.split(key, 32))

    def nrm(shape, scale):
        return scale * jax.random.normal(next(keys), shape, jnp.float32)

    def gain(shape):
        return 1.0 + nrm(shape, 0.02)

    return {
        "x_prompt": nrm((BATCH, SEQ, D_MODEL), 1.0),
        "x_sample": nrm((DEC_BATCH, DEC_SEQ, D_MODEL), 1.0),
        "p_prompt": nrm((DEPTH, BATCH, SEQ, PLE_DIM), 1.0),
        "p_sample": nrm((DEPTH, DEC_BATCH, DEC_SEQ, PLE_DIM), 1.0),
        "rel_bias_table": nrm((T5_BUCKETS, A_HEADS), 0.1),
        "norm_mix": gain((DEPTH, D_MODEL)),
        "norm_ffn": gain((DEPTH, D_MODEL)),
        "norm_ple": gain((DEPTH, D_MODEL)),
        "final_norm": gain((D_MODEL,)),
        "ab_w_in": nrm((N_EVEN, D_MODEL, AB_IN), D_MODEL ** -0.5),
        "ab_w_out": nrm((N_EVEN, AB_OUT, D_MODEL), AB_OUT ** -0.5),
        "diff_lambda": nrm((N_EVEN, 4, A_QK_DIM), 0.1),
        "diff_subln": gain((N_EVEN, A_V_DIM)),
        "na_bias": nrm((N_EVEN, B_HEADS, 2 * NA_ROWS - 1, 2 * NA_COLS - 1), 0.1),
        "c_w_in": nrm((N_ODD, D_MODEL, 3 * C_WIDTH), D_MODEL ** -0.5),
        "c_conv_w": nrm((N_ODD, SHORT_CONV, 3 * C_WIDTH), SHORT_CONV ** -0.5),
        "c_conv_b": nrm((N_ODD, 3 * C_WIDTH), 0.02),
        "c_filt_w1": nrm((N_ODD, FILTER_EMB, FILTER_HIDDEN), FILTER_EMB ** -0.5),
        "c_filt_b1": nrm((N_ODD, FILTER_HIDDEN), 0.02),
        "c_filt_freq": gain((N_ODD, 2, FILTER_HIDDEN)),
        "c_filt_w2": nrm((N_ODD, FILTER_HIDDEN, FILTER_HIDDEN), FILTER_HIDDEN ** -0.5),
        "c_filt_b2": nrm((N_ODD, FILTER_HIDDEN), 0.02),
        "c_filt_w3": nrm((N_ODD, FILTER_HIDDEN, 2 * C_WIDTH), 0.05 * FILTER_HIDDEN ** -0.5),
        "c_skip": nrm((N_ODD, C_WIDTH), 0.5),
        "c_w_out": nrm((N_ODD, C_WIDTH, D_MODEL), C_WIDTH ** -0.5),
        "ffn_w_in": nrm((DEPTH, D_MODEL, 2 * D_FF), D_MODEL ** -0.5),
        "ffn_w_out": nrm((DEPTH, D_FF, D_MODEL), D_FF ** -0.5),
        "ple_w_proj": nrm((DEPTH, PLE_DIM, D_MODEL), PLE_DIM ** -0.5),
        "ple_w_gate": nrm((DEPTH, D_MODEL, D_MODEL), D_MODEL ** -0.5),
    }


def reference(x_prompt, x_sample, p_prompt, p_sample, rel_bias_table, norm_mix, norm_ffn,
              norm_ple, final_norm, ab_w_in, ab_w_out, diff_lambda, diff_subln, na_bias,
              c_w_in, c_conv_w, c_conv_b, c_filt_w1, c_filt_b1, c_filt_freq, c_filt_w2,
              c_filt_b2, c_filt_w3, c_skip, c_w_out, ffn_w_in, ffn_w_out, ple_w_proj, ple_w_gate):
    W = dict(rel_bias_table=rel_bias_table, norm_mix=norm_mix, norm_ffn=norm_ffn,
             norm_ple=norm_ple, final_norm=final_norm, ab_w_in=ab_w_in, ab_w_out=ab_w_out,
             diff_lambda=diff_lambda, diff_subln=diff_subln, na_bias=na_bias,
             c_w_in=c_w_in, c_conv_w=c_conv_w, c_conv_b=c_conv_b, c_filt_w1=c_filt_w1,
             c_filt_b1=c_filt_b1, c_filt_freq=c_filt_freq, c_filt_w2=c_filt_w2,
             c_filt_b2=c_filt_b2, c_filt_w3=c_filt_w3, c_skip=c_skip, c_w_out=c_w_out,
             ffn_w_in=ffn_w_in, ffn_w_out=ffn_w_out, ple_w_proj=ple_w_proj,
             ple_w_gate=ple_w_gate)
    y_prompt = trunk(x_prompt, p_prompt, W)
    y_sample = trunk(x_sample, p_sample, W)
    return (y_prompt, y_sample)
```

```cpp
#include <hip/hip_runtime.h>
#include <hip/hip_cooperative_groups.h>
#include <cstdio>
#include <cstdint>
namespace cg = cooperative_groups;
namespace pg8 {
#define PG8_LAS __attribute__((address_space(3)))
typedef unsigned short bf16_t;
typedef short bf16x8 __attribute__((ext_vector_type(8)));
typedef float f32x4 __attribute__((ext_vector_type(4)));
typedef unsigned u32x4 __attribute__((ext_vector_type(4)));
constexpr int BM = 256, BK = 64, HALF = 128, HTB = HALF * BK * 2  , STAGE_BYTES = 8 * HTB, NXCD = 8;

__host__ __device__ __forceinline__ int lds_byte(int r, int c) { const int st = (r >> 4) * 2 + (c >> 5), rr = r & 15, cc = c & 31, ob = rr * 64 + cc * 2; return st * 1024 + (ob ^ (((ob >> 9) & 1) << 5)); }
__host__ __device__ __forceinline__ void stage_rc(int b, int& R, int& C) { const int st = b / 1024, sb = b % 1024, swz = sb ^ (((sb >> 9) & 1) << 5); R = (st >> 1) * 16 + swz / 64; C = (st & 1) * 32 + (swz % 64) / 2; }
__host__ __device__ __forceinline__ int perm32(int rho) { const int n = rho >> 4, i = rho & 15; return 8 * (i >> 2) + 4 * n + (i & 3); }

struct Unit { int pm, pn; };
struct Gemm { const bf16_t* A; const bf16_t* Bt; int M, N, K; };

struct StaticOrder {
    int nM, nN, nwg, G, c, WGM;
    __host__ __device__ void init(int M, int N, int G_, int c_, int wgm_ = 4) { nM = M / BM; nN = N / BM; nwg = nM * nN; G = G_; c = c_; WGM = wgm_; }
    __host__ __device__ bool next(int i, Unit& u) const {
        const long L = (long)i * G + c; if (L >= nwg) return false;
        int wgid = (int)L; { const int q = nwg / NXCD, r = nwg % NXCD, xcd = wgid % NXCD, off = wgid / NXCD; wgid = (xcd < r ? xcd * (q + 1) : r * (q + 1) + (xcd - r) * q) + off; }
        const int nig = WGM * nN, gid = wgid / nig, fm = gid * WGM, gsz = (nM - fm) < WGM ? (nM - fm) : WGM;
        u.pm = fm + ((wgid % nig) % gsz); u.pn = (wgid % nig) / gsz; return true;
    }
    __device__ __forceinline__ void a_ready(const Unit&) const {}
    __device__ __forceinline__ void done(const Unit&) const {}
};

typedef float f32x2c_t __attribute__((ext_vector_type(2))); typedef __bf16 bf16x2c_t __attribute__((ext_vector_type(2)));
__device__ __forceinline__ unsigned cvt_pk_bf16(float lo, float hi) { f32x2c_t v = {lo, hi}; bf16x2c_t b = __builtin_convertvector(v, bf16x2c_t); return __builtin_bit_cast(unsigned, b); }
typedef float f32x2 __attribute__((ext_vector_type(2)));
__device__ __forceinline__ float bf2f(unsigned short b) { return __uint_as_float(((unsigned)b) << 16); }
__device__ __forceinline__ float rs_of(const float* RSV, int row) { return RSV[row]; }
template <bool RS> struct EpiSplit {
    static constexpr bool PERM = true, AFTER_DRAIN = false;
    bf16_t* O; int ldc; int split_cols; size_t split_stride; const float* SS;
    __device__ __forceinline__ void operator()(const f32x4 (&acc)[2][2][4][2], const Unit& u, int wr, int wc, int fr, int fq) const {
        const int row0 = u.pm * BM + wr * 64 + fr; int colt = u.pn * BM; bf16_t* base = O;
        { const int t = colt / split_cols; base += (size_t)t * split_stride; colt -= t * split_cols; }
        const int col0 = colt + wc * 32 + 8 * fq;
        float rsv[2][4];
#pragma unroll
        for (int ai = 0; ai < 2; ++ai)
#pragma unroll
            for (int m = 0; m < 4; ++m) rsv[ai][m] = RS ? rs_of(SS, row0 + ai * HALF + m * 16) : 1.0f;
#pragma unroll
        for (int ai = 0; ai < 2; ++ai)
#pragma unroll
            for (int m = 0; m < 4; ++m) { bf16_t* rowp = base + (size_t)(row0 + ai * HALF + m * 16) * ldc + col0;
                const float rs = rsv[ai][m];
#pragma unroll
                for (int bj = 0; bj < 2; ++bj) { f32x4 v0 = acc[ai][bj][m][0], v1 = acc[ai][bj][m][1];
                    if (RS) { v0 = v0 * rs; v1 = v1 * rs; }
                    u32x4 w; w.x = cvt_pk_bf16(v0[0], v0[1]); w.y = cvt_pk_bf16(v0[2], v0[3]); w.z = cvt_pk_bf16(v1[0], v1[1]); w.w = cvt_pk_bf16(v1[2], v1[3]);
                    *(u32x4*)(rowp + bj * HALF) = w; } }
    }
};
template <bool RS> struct EpiSigmoid {
    static constexpr bool PERM = true, AFTER_DRAIN = false;
    bf16_t* O; int ldc; const float* SS;
    static __device__ __forceinline__ float sg(float x) { return __builtin_amdgcn_rcpf(1.0f + __builtin_amdgcn_exp2f(-1.4426950408889634f * x)); }
    __device__ __forceinline__ void operator()(const f32x4 (&acc)[2][2][4][2], const Unit& u, int wr, int wc, int fr, int fq) const {
        const int row0 = u.pm * BM + wr * 64 + fr; const int col0 = u.pn * BM + wc * 32 + 8 * fq;
        float rsv[2][4];
#pragma unroll
        for (int ai = 0; ai < 2; ++ai)
#pragma unroll
            for (int m = 0; m < 4; ++m) rsv[ai][m] = RS ? rs_of(SS, row0 + ai * HALF + m * 16) : 1.0f;
#pragma unroll
        for (int ai = 0; ai < 2; ++ai)
#pragma unroll
            for (int m = 0; m < 4; ++m) { bf16_t* rowp = O + (size_t)(row0 + ai * HALF + m * 16) * ldc + col0;
                const float rs = rsv[ai][m];
#pragma unroll
                for (int bj = 0; bj < 2; ++bj) { f32x4 v0 = acc[ai][bj][m][0], v1 = acc[ai][bj][m][1];
                    if (RS) { v0 = v0 * rs; v1 = v1 * rs; }
                    u32x4 w; w.x = cvt_pk_bf16(sg(v0[0]), sg(v0[1])); w.y = cvt_pk_bf16(sg(v0[2]), sg(v0[3])); w.z = cvt_pk_bf16(sg(v1[0]), sg(v1[1])); w.w = cvt_pk_bf16(sg(v1[2]), sg(v1[3]));
                    *(u32x4*)(rowp + bj * HALF) = w; } }
    }
};
template <bool RS> struct EpiSwiGLU {
    static constexpr bool PERM = true, AFTER_DRAIN = false;
    bf16_t* O; int ldc; const float* SS;
    static __device__ __forceinline__ float sl(float g, float up) { return g * __builtin_amdgcn_rcpf(1.0f + __builtin_amdgcn_exp2f(-1.4426950408889634f * g)) * up; }
    __device__ __forceinline__ void operator()(const f32x4 (&acc)[2][2][4][2], const Unit& u, int wr, int wc, int fr, int fq) const {
        const int row0 = u.pm * BM + wr * 64 + fr; const int col0 = u.pn * HALF + wc * 32 + 8 * fq;
        float rsv[2][4];
#pragma unroll
        for (int ai = 0; ai < 2; ++ai)
#pragma unroll
            for (int m = 0; m < 4; ++m) rsv[ai][m] = RS ? rs_of(SS, row0 + ai * HALF + m * 16) : 1.0f;
#pragma unroll
        for (int ai = 0; ai < 2; ++ai)
#pragma unroll
            for (int m = 0; m < 4; ++m) { bf16_t* rowp = O + (size_t)(row0 + ai * HALF + m * 16) * ldc + col0;
                f32x4 g0 = acc[ai][0][m][0], g1 = acc[ai][0][m][1], u0 = acc[ai][1][m][0], u1 = acc[ai][1][m][1];
                if (RS) { const float rs = rsv[ai][m]; g0 = g0 * rs; g1 = g1 * rs; u0 = u0 * rs; u1 = u1 * rs; }
                u32x4 w; w.x = cvt_pk_bf16(sl(g0[0], u0[0]), sl(g0[1], u0[1])); w.y = cvt_pk_bf16(sl(g0[2], u0[2]), sl(g0[3], u0[3]));
                w.z = cvt_pk_bf16(sl(g1[0], u1[0]), sl(g1[1], u1[1])); w.w = cvt_pk_bf16(sl(g1[2], u1[2]), sl(g1[3], u1[3]));
                *(u32x4*)rowp = w; }
    }
};
struct EpiResAddB {
    static constexpr bool PERM = false, AFTER_DRAIN = false;
    bf16_t* HB; int ldc; float* SS;
    __device__ __forceinline__ void operator()(const f32x4 (&acc)[2][2][4][2], const Unit& u, int wr, int wc, int fr, int fq) const {
        const int row0 = u.pm * BM + wr * 64 + fr, col0 = u.pn * BM + wc * 32 + 4 * fq;
#pragma unroll
        for (int ai = 0; ai < 2; ++ai) {
            uint2 o[4][2][2];
#pragma unroll
            for (int m = 0; m < 4; ++m)
#pragma unroll
                for (int bj = 0; bj < 2; ++bj)
#pragma unroll
                    for (int n = 0; n < 2; ++n) o[m][bj][n] = *(const uint2*)(HB + (size_t)(row0 + ai * HALF + m * 16) * ldc + col0 + bj * HALF + n * 16);
#pragma unroll
            for (int m = 0; m < 4; ++m) { const size_t off = (size_t)(row0 + ai * HALF + m * 16) * ldc + col0; float ss = 0.f;
#pragma unroll
                for (int bj = 0; bj < 2; ++bj)
#pragma unroll
                    for (int n = 0; n < 2; ++n) { const uint2 ov = o[m][bj][n]; const f32x4 a = acc[ai][bj][m][n];
                        uint2 w; w.x = cvt_pk_bf16(__uint_as_float(ov.x << 16) + a[0], __uint_as_float(ov.x & 0xffff0000u) + a[1]);
                        w.y = cvt_pk_bf16(__uint_as_float(ov.y << 16) + a[2], __uint_as_float(ov.y & 0xffff0000u) + a[3]); *(uint2*)(HB + off + bj * HALF + n * 16) = w;
                        const float h0 = __uint_as_float(w.x << 16), h1 = __uint_as_float(w.x & 0xffff0000u), h2 = __uint_as_float(w.y << 16), h3 = __uint_as_float(w.y & 0xffff0000u);
                        ss += (h0 * h0 + h1 * h1) + (h2 * h2 + h3 * h3); }
                ss += __shfl_xor(ss, 16); ss += __shfl_xor(ss, 32); if (fq == 0) SS[(size_t)(row0 + ai * HALF + m * 16) * 32 + u.pn * 4 + wc] = ss; }
            asm volatile("" ::: "memory"); }
    }
};
struct EpiGateResB {
    static constexpr bool PERM = false, AFTER_DRAIN = false;
    bf16_t* HB; const bf16_t* G; int ldc; float* SS;
    __device__ __forceinline__ void operator()(const f32x4 (&acc)[2][2][4][2], const Unit& u, int wr, int wc, int fr, int fq) const {
        const int row0 = u.pm * BM + wr * 64 + fr, col0 = u.pn * BM + wc * 32 + 4 * fq;
#pragma unroll
        for (int ai = 0; ai < 2; ++ai) {
            uint2 o[4][2][2], gq[4][2][2];
#pragma unroll
            for (int m = 0; m < 4; ++m)
#pragma unroll
                for (int bj = 0; bj < 2; ++bj)
#pragma unroll
                    for (int n = 0; n < 2; ++n) { const size_t off = (size_t)(row0 + ai * HALF + m * 16) * ldc + col0 + bj * HALF + n * 16; o[m][bj][n] = *(const uint2*)(HB + off); gq[m][bj][n] = *(const uint2*)(G + off); }
#pragma unroll
            for (int m = 0; m < 4; ++m) { const size_t off = (size_t)(row0 + ai * HALF + m * 16) * ldc + col0; float ss = 0.f;
#pragma unroll
                for (int bj = 0; bj < 2; ++bj)
#pragma unroll
                    for (int n = 0; n < 2; ++n) { const uint2 ov = o[m][bj][n], gw = gq[m][bj][n]; const f32x4 a = acc[ai][bj][m][n];
                        uint2 w; w.x = cvt_pk_bf16(fmaf(a[0], __uint_as_float(gw.x << 16), __uint_as_float(ov.x << 16)), fmaf(a[1], __uint_as_float(gw.x & 0xffff0000u), __uint_as_float(ov.x & 0xffff0000u)));
                        w.y = cvt_pk_bf16(fmaf(a[2], __uint_as_float(gw.y << 16), __uint_as_float(ov.y << 16)), fmaf(a[3], __uint_as_float(gw.y & 0xffff0000u), __uint_as_float(ov.y & 0xffff0000u))); *(uint2*)(HB + off + bj * HALF + n * 16) = w;
                        const float h0 = __uint_as_float(w.x << 16), h1 = __uint_as_float(w.x & 0xffff0000u), h2 = __uint_as_float(w.y << 16), h3 = __uint_as_float(w.y & 0xffff0000u);
                        ss += (h0 * h0 + h1 * h1) + (h2 * h2 + h3 * h3); }
                ss += __shfl_xor(ss, 16); ss += __shfl_xor(ss, 32); if (fq == 0) SS[(size_t)(row0 + ai * HALF + m * 16) * 32 + u.pn * 4 + wc] = ss; }
            asm volatile("" ::: "memory"); }
    }
};
template <class Epi, class Sched, bool ALIGN_EPI = false, bool SP2 = false>
__device__ __forceinline__ void gemm_phase(PG8_LAS unsigned char* lds, const Gemm g, const Sched& S, const Epi& E) {
    int tid = threadIdx.x; asm volatile("" : "+v"(tid)); const int wid = __builtin_amdgcn_readfirstlane(tid >> 6), lane = tid & 63, wr = wid >> 2, wc = wid & 3, fr = lane & 15, fq = lane >> 4;
    const int K = g.K, nt = K / BK;
    unsigned voffA[2], voffB[2];
#pragma unroll
    for (int i = 0; i < 2; ++i) { int R, C; stage_rc(tid * 16 + i * 8192, R, C); const int Rb = Epi::PERM ? ((R & ~31) + perm32(R & 31)) : R;
        voffA[i] = (unsigned)(R * K + C) * 2u; voffB[i] = (unsigned)(Rb * K + C) * 2u; }
    const size_t kstep = (size_t)(BK * 2);
    const size_t hstep = (size_t)HALF * K * 2;
    const size_t tstep = 2 * hstep;
    const unsigned ldsw = (unsigned)wid * 1024u;
    const int aoff = lds_byte(wr * 64 + fr, fq * 8), boff = lds_byte(wc * 32 + fr, fq * 8);
#define PG8_SA(b, h) (((b) * 2 + (h)) * HTB)
#define PG8_SB(b, h) ((4 + (b) * 2 + (h)) * HTB)
#define PG8_STAGE(bufoff, gbase, voff) do { _Pragma("unroll") for (int _i = 0; _i < 2; ++_i) \
        __builtin_amdgcn_global_load_lds((const unsigned*)((const char*)(gbase) + (voff)[_i]), (PG8_LAS unsigned*)(lds + (bufoff) + ldsw + _i * 8192), 16, 0, 0); } while (0)
#define PG8_LDA(dst, b, h) do { _Pragma("unroll") for (int m = 0; m < 4; ++m) _Pragma("unroll") for (int k = 0; k < 2; ++k) dst[m][k] = *(const PG8_LAS bf16x8*)(lds + PG8_SA(b, h) + aoff + m * 2048 + k * 1024); } while (0)
#define PG8_LDB(dst, b, h) do { _Pragma("unroll") for (int n = 0; n < 2; ++n) _Pragma("unroll") for (int k = 0; k < 2; ++k) dst[n][k] = *(const PG8_LAS bf16x8*)(lds + PG8_SB(b, h) + boff + n * 2048 + k * 1024); } while (0)
#define PG8_MMA(ai, bj, At, Bt) do { __builtin_amdgcn_s_setprio(1); _Pragma("unroll") for (int m = 0; m < 4; ++m) _Pragma("unroll") for (int n = 0; n < 2; ++n) _Pragma("unroll") for (int k = 0; k < 2; ++k) \
        acc[ai][bj][m][n] = __builtin_amdgcn_mfma_f32_16x16x32_bf16(Bt[n][k], At[m][k], acc[ai][bj][m][n], 0, 0, 0); __builtin_amdgcn_s_setprio(0); } while (0)
#define PG8_WAIT_V(n) asm volatile("s_waitcnt vmcnt(" #n ")" ::: "memory")
#define PG8_WAIT_L(n) asm volatile("s_waitcnt lgkmcnt(" #n ")" ::: "memory")
#define PG8_BAR __builtin_amdgcn_s_barrier()
#define PG8_SCHED __builtin_amdgcn_sched_barrier(0)
    Unit cur, nxt; int ui = 0;
    if (!S.next(0, cur)) return;
    f32x4 acc[2][2][4][2];
#pragma unroll
    for (int a = 0; a < 2; ++a)
#pragma unroll
        for (int b = 0; b < 2; ++b)
#pragma unroll
            for (int m = 0; m < 4; ++m)
#pragma unroll
                for (int n = 0; n < 2; ++n) acc[a][b][m][n] = (f32x4){0.f, 0.f, 0.f, 0.f};
    bf16x8 At[4][2], B0[2][2], B1[2][2];
    const char* cA = (const char*)g.A + (size_t)cur.pm * tstep; const char* cB = (const char*)g.Bt + (size_t)cur.pn * tstep;
    S.a_ready(cur);
    if constexpr (SP2) {
        PG8_STAGE(PG8_SB(0, 0), cB, voffB); PG8_STAGE(PG8_SB(0, 1), cB + hstep, voffB); PG8_STAGE(PG8_SA(0, 0), cA, voffA); PG8_STAGE(PG8_SA(0, 1), cA + hstep, voffA);
        if (wr == 1) PG8_BAR;
        PG8_WAIT_V(2); PG8_BAR;
        PG8_STAGE(PG8_SB(1, 0), cB + kstep, voffB); PG8_STAGE(PG8_SA(1, 0), cA + kstep, voffA); PG8_STAGE(PG8_SB(1, 1), cB + hstep + kstep, voffB);
        PG8_WAIT_V(6); PG8_BAR;
    } else {
        PG8_STAGE(PG8_SB(0, 0), cB, voffB); PG8_STAGE(PG8_SA(0, 0), cA, voffA); PG8_STAGE(PG8_SB(0, 1), cB + hstep, voffB); PG8_STAGE(PG8_SA(0, 1), cA + hstep, voffA);
        if (wr == 1) PG8_BAR;
        PG8_WAIT_V(4); PG8_BAR;
        PG8_STAGE(PG8_SB(1, 0), cB + kstep, voffB); PG8_STAGE(PG8_SA(1, 0), cA + kstep, voffA); PG8_STAGE(PG8_SB(1, 1), cB + hstep + kstep, voffB);
        PG8_WAIT_V(6); PG8_BAR;
    }
    for (;;) {
        const bool has_next = S.next(ui + 1, nxt);
        const char* nA = has_next ? (const char*)g.A + (size_t)nxt.pm * tstep : cA; const char* nB = has_next ? (const char*)g.Bt + (size_t)nxt.pn * tstep : cB;
        for (int t = 0; t < nt; t += 2) {
            const bool last = (t == nt - 2);
            const char* a1 = cA + (size_t)(t + 1) * kstep;
            const char* a2 = last ? nA : cA + (size_t)(t + 2) * kstep; const char* b2 = last ? nB : cB + (size_t)(t + 2) * kstep;
            const char* a3 = a2 + kstep; const char* b3 = b2 + kstep;
            if (last && has_next) S.a_ready(nxt);
            if constexpr (SP2) {
            PG8_LDB(B0, 0, 0); PG8_LDB(B1, 0, 1); PG8_SCHED; PG8_LDA(At, 0, 0); PG8_STAGE(PG8_SA(1, 1), a1 + hstep, voffA);
            PG8_WAIT_V(8); PG8_WAIT_L(0); PG8_BAR; PG8_MMA(0, 0, At, B0); PG8_MMA(0, 1, At, B1); PG8_BAR; PG8_SCHED;
            PG8_LDA(At, 0, 1); PG8_STAGE(PG8_SB(0, 0), b2, voffB); PG8_STAGE(PG8_SB(0, 1), b2 + hstep, voffB); PG8_STAGE(PG8_SA(0, 0), a2, voffA);
            PG8_WAIT_V(8); PG8_WAIT_L(0); PG8_BAR; PG8_MMA(1, 0, At, B0); PG8_MMA(1, 1, At, B1); PG8_BAR; PG8_SCHED;
            PG8_LDB(B0, 1, 0); PG8_LDB(B1, 1, 1); PG8_SCHED; PG8_LDA(At, 1, 0); PG8_STAGE(PG8_SA(0, 1), a2 + hstep, voffA);
            PG8_WAIT_V(8); PG8_WAIT_L(0); PG8_BAR; PG8_MMA(0, 0, At, B0); PG8_MMA(0, 1, At, B1); PG8_BAR; PG8_SCHED;
            PG8_LDA(At, 1, 1); PG8_STAGE(PG8_SB(1, 0), b3, voffB); PG8_STAGE(PG8_SB(1, 1), b3 + hstep, voffB); PG8_STAGE(PG8_SA(1, 0), a3, voffA);
            PG8_WAIT_V(8); PG8_WAIT_L(0); PG8_BAR; PG8_MMA(1, 0, At, B0); PG8_MMA(1, 1, At, B1); PG8_BAR; PG8_SCHED;
            } else {
            PG8_LDB(B0, 0, 0); PG8_SCHED; PG8_LDA(At, 0, 0); PG8_STAGE(PG8_SA(1, 1), a1 + hstep, voffA);
            PG8_WAIT_L(8); PG8_BAR; PG8_WAIT_L(0); PG8_MMA(0, 0, At, B0); PG8_BAR; PG8_SCHED;
            PG8_LDB(B1, 0, 1); PG8_STAGE(PG8_SB(0, 0), b2, voffB);
            PG8_BAR; PG8_WAIT_L(0); PG8_MMA(0, 1, At, B1); PG8_BAR;
            PG8_LDA(At, 0, 1); PG8_STAGE(PG8_SA(0, 0), a2, voffA);
            PG8_BAR; PG8_WAIT_L(0); PG8_MMA(1, 0, At, B0); PG8_BAR; PG8_SCHED;
            PG8_STAGE(PG8_SB(0, 1), b2 + hstep, voffB);
            PG8_WAIT_V(6); PG8_BAR; PG8_MMA(1, 1, At, B1); PG8_BAR;
            PG8_LDB(B0, 1, 0); PG8_SCHED; PG8_LDA(At, 1, 0); PG8_STAGE(PG8_SA(0, 1), a2 + hstep, voffA);
            PG8_WAIT_L(8); PG8_BAR; PG8_WAIT_L(0); PG8_MMA(0, 0, At, B0); PG8_BAR; PG8_SCHED;
            PG8_LDB(B1, 1, 1); PG8_STAGE(PG8_SB(1, 0), b3, voffB);
            PG8_BAR; PG8_WAIT_L(0); PG8_MMA(0, 1, At, B1); PG8_BAR;
            PG8_LDA(At, 1, 1); PG8_STAGE(PG8_SA(1, 0), a3, voffA);
            PG8_BAR; PG8_WAIT_L(0); PG8_MMA(1, 0, At, B0); PG8_BAR; PG8_SCHED;
            PG8_STAGE(PG8_SB(1, 1), b3 + hstep, voffB);
            PG8_WAIT_V(6); PG8_BAR; PG8_MMA(1, 1, At, B1); PG8_BAR;
            }
        }
        if constexpr (ALIGN_EPI) { if (wr == 0) PG8_BAR; }
        if constexpr (!Epi::AFTER_DRAIN) { E(acc, cur, wr, wc, fr, fq); S.done(cur); }
        if (!has_next) break;
#pragma unroll
        for (int a = 0; a < 2; ++a)
#pragma unroll
            for (int b = 0; b < 2; ++b)
#pragma unroll
                for (int m = 0; m < 4; ++m)
#pragma unroll
                    for (int n = 0; n < 2; ++n) acc[a][b][m][n] = (f32x4){0.f, 0.f, 0.f, 0.f};
        cur = nxt; cA = nA; cB = nB; ++ui;
        if constexpr (ALIGN_EPI) { if (wr == 1) PG8_BAR; }
    }
    PG8_WAIT_V(0);
    if constexpr (!ALIGN_EPI) { if (wr == 0) PG8_BAR; }
    PG8_BAR;
    if constexpr (Epi::AFTER_DRAIN) { E.fused(acc, cur, wr, wc, fr, fq, lds, wid, lane); S.done(cur); }
#undef PG8_SA
#undef PG8_SB
#undef PG8_STAGE
#undef PG8_LDA
#undef PG8_LDB
#undef PG8_MMA
#undef PG8_WAIT_V
#undef PG8_WAIT_L
#undef PG8_BAR
#undef PG8_SCHED
}
}
namespace att {
using bf16x8 = __attribute__((ext_vector_type(8))) short;
using s16x4  = __attribute__((ext_vector_type(4))) short;
using f32x16 = __attribute__((ext_vector_type(16))) float;
using u32x4  = __attribute__((ext_vector_type(4))) unsigned;
#define KSWZ(row, colB) ((row) * 256 + ((colB) ^ (((row) & 7) << 4)))
#define SBAR() __builtin_amdgcn_sched_barrier(0)
__device__ __forceinline__ int crow(int r, int hi) { return (r & 3) + 8 * (r >> 2) + 4 * hi; }
typedef float f32x2a_t __attribute__((ext_vector_type(2))); typedef __bf16 bf16x2a_t __attribute__((ext_vector_type(2)));
__device__ __forceinline__ unsigned cvtpk(float lo, float hi) { f32x2a_t v = {lo, hi}; bf16x2a_t b = __builtin_convertvector(v, bf16x2a_t); return __builtin_bit_cast(unsigned, b); }
__device__ __forceinline__ int v_st(int k, int c) { const int kk = (k & ~0xC) | ((k & 4) << 1) | ((k & 8) >> 1); return ((kk >> 3) * 4 + (c >> 5)) * 512 + ((kk & 7) * 32 + (c & 31)) * 2; }
__device__ __forceinline__ int v_rd_base(int lane) { return ((lane & 3) << 3) | (((lane >> 2) & 3) << 6) | (((lane >> 4) & 1) << 5) | (((lane >> 5) & 1) << 8); }
constexpr int v_rd_off(int d0, int ks, int half) { return d0 * 512 + ks * 4096 + half * 2048; }
template <int OFF> __device__ __forceinline__ s16x4 tr_read(int vb) {
  s16x4 r; asm volatile("ds_read_b64_tr_b16 %0, %1 offset:%2" : "=&v"(r) : "v"(vb), "i"(OFF) : "memory"); return r;
}
template <int D0> __device__ __forceinline__ void pv_one(f32x16& od, int vb, bf16x8 pa0, bf16x8 pa1, bf16x8 pa2, bf16x8 pa3) {
  const s16x4 l0 = tr_read<v_rd_off(D0, 0, 0)>(vb), h0 = tr_read<v_rd_off(D0, 0, 1)>(vb), l1 = tr_read<v_rd_off(D0, 1, 0)>(vb), h1 = tr_read<v_rd_off(D0, 1, 1)>(vb);
  const s16x4 l2 = tr_read<v_rd_off(D0, 2, 0)>(vb), h2 = tr_read<v_rd_off(D0, 2, 1)>(vb), l3 = tr_read<v_rd_off(D0, 3, 0)>(vb), h3 = tr_read<v_rd_off(D0, 3, 1)>(vb);
  asm volatile("s_waitcnt lgkmcnt(0)" ::: "memory"); SBAR();
#define PK(L, H) (bf16x8){L[0], L[1], L[2], L[3], H[0], H[1], H[2], H[3]}
  od = __builtin_amdgcn_mfma_f32_32x32x16_bf16(pa0, PK(l0, h0), od, 0, 0, 0);
  od = __builtin_amdgcn_mfma_f32_32x32x16_bf16(pa1, PK(l1, h1), od, 0, 0, 0);
  od = __builtin_amdgcn_mfma_f32_32x32x16_bf16(pa2, PK(l2, h2), od, 0, 0, 0);
  od = __builtin_amdgcn_mfma_f32_32x32x16_bf16(pa3, PK(l3, h3), od, 0, 0, 0);
#undef PK
}
template <int KS> __device__ __forceinline__ void pv_step(f32x16* o, int vb, bf16x8 pa) {
  const s16x4 l0 = tr_read<v_rd_off(0, KS, 0)>(vb), h0 = tr_read<v_rd_off(0, KS, 1)>(vb), l1 = tr_read<v_rd_off(1, KS, 0)>(vb), h1 = tr_read<v_rd_off(1, KS, 1)>(vb);
  const s16x4 l2 = tr_read<v_rd_off(2, KS, 0)>(vb), h2 = tr_read<v_rd_off(2, KS, 1)>(vb), l3 = tr_read<v_rd_off(3, KS, 0)>(vb), h3 = tr_read<v_rd_off(3, KS, 1)>(vb);
  asm volatile("s_waitcnt lgkmcnt(0)" ::: "memory"); SBAR();
#define PK(L, H) (bf16x8){L[0], L[1], L[2], L[3], H[0], H[1], H[2], H[3]}
  o[0] = __builtin_amdgcn_mfma_f32_32x32x16_bf16(pa, PK(l0, h0), o[0], 0, 0, 0);
  o[1] = __builtin_amdgcn_mfma_f32_32x32x16_bf16(pa, PK(l1, h1), o[1], 0, 0, 0);
  o[2] = __builtin_amdgcn_mfma_f32_32x32x16_bf16(pa, PK(l2, h2), o[2], 0, 0, 0);
  o[3] = __builtin_amdgcn_mfma_f32_32x32x16_bf16(pa, PK(l3, h3), o[3], 0, 0, 0);
#undef PK
}
__device__ __forceinline__ void pv_d0(f32x16* o, int vb, bf16x8 pa0, bf16x8 pa1, bf16x8 pa2, bf16x8 pa3) {
  pv_step<0>(o, vb, pa0); pv_step<1>(o, vb, pa1); pv_step<2>(o, vb, pa2); pv_step<3>(o, vb, pa3);
}

typedef unsigned short bf16;
__device__ __forceinline__ unsigned short f2bf(float f) { unsigned u = __float_as_uint(f); return (unsigned short)((u + 0x7fffu + ((u >> 16) & 1u)) >> 16); }

template <bool DIFF>
__device__ __forceinline__ void qkt(f32x16& a, f32x16& b, const char* Ks, const char* Qs, int krow, int r32, int hi) {
  a = f32x16{}; b = f32x16{};
#pragma unroll
  for (int d = 0; d < 4; ++d) {
    const int cb0 = (d * 16 + hi * 8) * 2, cb1 = ((d + 4) * 16 + hi * 8) * 2;
    const bf16x8 k0 = *reinterpret_cast<const bf16x8*>(Ks + KSWZ(krow, cb0)), q0 = *reinterpret_cast<const bf16x8*>(Qs + KSWZ(r32, cb0));
    const bf16x8 k1 = *reinterpret_cast<const bf16x8*>(Ks + KSWZ(krow, cb1)), q1 = *reinterpret_cast<const bf16x8*>(Qs + KSWZ(r32, cb1));
    a = __builtin_amdgcn_mfma_f32_32x32x16_bf16(k0, q0, a, 0, 0, 0);
    b = __builtin_amdgcn_mfma_f32_32x32x16_bf16(k1, q1, b, 0, 0, 0); }
  if (!DIFF) {
#pragma unroll
    for (int r = 0; r < 16; ++r) a[r] += b[r]; }
}
__device__ __forceinline__ void stat_upd(const f32x16& p0, float& m, float& l, const float C, const float cb) {
  float mx = p0[0];
#pragma unroll
  for (int r = 1; r < 16; ++r) mx = fmaxf(mx, p0[r]);
  { auto rr = __builtin_amdgcn_permlane32_swap(__float_as_uint(mx), __float_as_uint(mx), false, false);
    mx = fmaxf(__uint_as_float(rr[0]), __uint_as_float(rr[1])); }
  mx += cb;
  const float mn = fmaxf(m, mx), alpha = __builtin_amdgcn_exp2f((m - mn) * C), mnC = (cb - mn) * C; float s = 0.f;
#pragma unroll
  for (int r = 0; r < 16; ++r) s += __builtin_amdgcn_exp2f(fmaf(p0[r], C, mnC));
  l = l * alpha + s; m = mn;
}
__device__ __forceinline__ int t5_bucket(int rel) {
  const int ret = rel > 0 ? 16 : 0; const int n = rel < 0 ? -rel : rel;
  const float nf = (float)(n > 1 ? n : 1);
  int large = 8 + (int)(logf(nf / 8.0f) / 2.7725887f * 8.0f); large = large < 15 ? large : 15;
  return ret + (n < 8 ? n : large);
}

template <bool DIFF>
__device__ __forceinline__ void attn_unit(const bf16* __restrict__ Qb, const bf16* __restrict__ Kb, const bf16* __restrict__ Vb, bf16* __restrict__ Ob,
                                          const int t_lo, const int t_hi, const int q0, const int rows, const float lam, const float* __restrict__ tabg, const int head,
                                          const float* __restrict__ subg, char* lds) {
  int tid = threadIdx.x; asm volatile("" : "+v"(tid)); const int wid = tid >> 6, lane = tid & 63, r32 = lane & 31, hi = lane >> 5;
  char* K_lds = lds; char* V_lds = lds + 16384; float* tab = (float*)(lds + 32768);
  constexpr float SCALE = DIFF ? 0.125f : 0.08838834764831845f;
  constexpr float C = SCALE * 1.4426950408889634f;
  __syncthreads();
  if (DIFF) { for (int i = tid; i < 257; i += 512) tab[i] = tabg[t5_bucket(i - 128) * 8 + head] * 8.0f; }
  else      { for (int i = tid; i < 465; i += 512) tab[i] = tabg[head * 465 + i] * 11.313708498984761f; }
  char* Q_lds = lds + 36864 + wid * 8192;
  { const bf16* Qw = Qb + (size_t)(wid * 32 + r32) * 1024 + hi * 8;
#pragma unroll
    for (int d0 = 0; d0 < 8; ++d0) *reinterpret_cast<bf16x8*>(Q_lds + KSWZ(r32, (d0 * 16 + hi * 8) * 2)) = *reinterpret_cast<const bf16x8*>(Qw + d0 * 16); }
  const int sr = tid >> 4, sc = (tid & 15) * 8;
  const int vst0 = v_st(sr, sc), vst1 = v_st(32 + sr, sc), kst0 = KSWZ(sr, sc * 2), kst1 = KSWZ(32 + sr, sc * 2);
  const int vb0 = (int)(uintptr_t)V_lds + v_rd_base(lane);
  int rw = 0, rstart = 0;
  if (!DIFF) { rw = q0 + (wid >> 1); rstart = rw - 4; rstart = rstart < 0 ? 0 : rstart; rstart = rstart > rows - 8 ? rows - 8 : rstart; }
  const int qbase = q0 + wid * 32;
  float m1 = -1e30f, l1 = 0.f, m2 = -1e30f, l2 = 0.f;
  bf16x8 ks0, ks1, vs0, vs1;
#define KLOAD(t) do { const bf16* kp_ = Kb + (size_t)((t) * 64 + sr) * 1024 + sc; ks0 = *reinterpret_cast<const bf16x8*>(kp_); ks1 = *reinterpret_cast<const bf16x8*>(kp_ + 32 * 1024); } while (0)
#define VLOAD(t) do { const bf16* vp_ = Vb + (size_t)((t) * 64 + sr) * 1024 + sc; vs0 = *reinterpret_cast<const bf16x8*>(vp_); vs1 = *reinterpret_cast<const bf16x8*>(vp_ + 32 * 1024); } while (0)
#define KWRITE() do { *reinterpret_cast<bf16x8*>(K_lds + kst0) = ks0; *reinterpret_cast<bf16x8*>(K_lds + kst1) = ks1; } while (0)
#define VWRITE() do { *reinterpret_cast<bf16x8*>(V_lds + vst0) = vs0; *reinterpret_cast<bf16x8*>(V_lds + vst1) = vs1; } while (0)
#define BIAS_APPLY(t, hf, A_, B_, CB_) do { CB_ = 0.f; \
    if (DIFF) { const int k0_ = (t) * 64; \
      if (k0_ - (qbase + 31) >= 128) { CB_ = tab[256]; } \
      else if (k0_ + 63 - qbase <= -128) { CB_ = tab[0]; } \
      else { const int base_ = k0_ - (qbase + r32) + 128 + 4 * hi + 32 * (hf); \
        _Pragma("unroll") for (int r = 0; r < 16; ++r) { int i0_ = base_ + (r & 3) + 8 * (r >> 2); \
          i0_ = i0_ < 0 ? 0 : (i0_ > 256 ? 256 : i0_); \
          const float v0_ = tab[i0_]; A_[r] += v0_; B_[r] += v0_; } } \
    } else { const int dr_ = (t) - rw + 7; const int qc_ = 32 * (wid & 1) + r32; int cs_ = qc_ - 8; cs_ = cs_ < 0 ? 0 : (cs_ > 48 ? 48 : cs_); \
      _Pragma("unroll") for (int r = 0; r < 16; ++r) { const int kc0_ = crow(r, hi) + 32 * (hf); \
        const bool ok0_ = (kc0_ >= cs_) && (kc0_ < cs_ + 16); \
        const float v0_ = tab[ok0_ ? dr_ * 31 + (kc0_ - qc_ + 15) : 0]; \
        A_[r] = ok0_ ? A_[r] + v0_ : -1e30f; } } } while (0)

  if (DIFF) {
  KLOAD(t_lo);
  for (int t = t_lo; t < t_hi; ++t) {
    __syncthreads();
    KWRITE();
    __syncthreads();
    if (t + 1 < t_hi) KLOAD(t + 1);
    const bool active = DIFF || (t >= rstart && t < rstart + 8);
    if (active) {
      f32x16 a0, b0, a1, b1;
      qkt<DIFF>(a0, b0, K_lds, Q_lds, r32, r32, hi);
      qkt<DIFF>(a1, b1, K_lds, Q_lds, r32 + 32, r32, hi);
      SBAR();
      float cb0, cb1;
      BIAS_APPLY(t, 0, a0, b0, cb0);
      stat_upd(a0, m1, l1, C, cb0);
      if (DIFF) stat_upd(b0, m2, l2, C, cb0);
      SBAR();
      BIAS_APPLY(t, 1, a1, b1, cb1);
      stat_upd(a1, m1, l1, C, cb1);
      if (DIFF) stat_upd(b1, m2, l2, C, cb1);
    }
  }
  { auto rr = __builtin_amdgcn_permlane32_swap(__float_as_uint(l1), __float_as_uint(l1), false, false); l1 = __uint_as_float(rr[0]) + __uint_as_float(rr[1]); }
  }
  if (DIFF) { auto rr = __builtin_amdgcn_permlane32_swap(__float_as_uint(l2), __float_as_uint(l2), false, false); l2 = __uint_as_float(rr[0]) + __uint_as_float(rr[1]); }
  float* const wsc = (float*)(lds + 34816) + wid * 64;
  const float e1 = DIFF ? -m1 * C - __builtin_amdgcn_logf(l1) : 0.f, e2 = DIFF ? -m2 * C + __builtin_amdgcn_logf(fabsf(lam) / l2) : 0.f, nsg = lam < 0.f ? 1.f : -1.f;

  f32x16 o[4];
#pragma unroll
  for (int d = 0; d < 4; ++d) o[d] = f32x16{};
  KLOAD(t_lo); VLOAD(t_lo);
  for (int t = t_lo; t < t_hi; ++t) {
    __syncthreads();
    KWRITE(); VWRITE();
    __syncthreads();
    if (t + 1 < t_hi) { KLOAD(t + 1); VLOAD(t + 1); }
    const bool active = DIFF || (t >= rstart && t < rstart + 8);
    if (active) {
      bf16x8 pa0, pa1, pa2, pa3;
#define PK4(P, BASE, OUT) do { unsigned x0_ = cvtpk(P[BASE + 0], P[BASE + 1]), x1_ = cvtpk(P[BASE + 2], P[BASE + 3]);   \
    unsigned y0_ = cvtpk(P[BASE + 4], P[BASE + 5]), y1_ = cvtpk(P[BASE + 6], P[BASE + 7]);                              \
    auto r0_ = __builtin_amdgcn_permlane32_swap(x0_, y0_, false, false); auto r1_ = __builtin_amdgcn_permlane32_swap(x1_, y1_, false, false); \
    u32x4 w_ = {r0_[0], r1_[0], r0_[1], r1_[1]}; OUT = *reinterpret_cast<bf16x8*>(&w_); } while (0)
      f32x16 a0, b0, a1, b1;
      qkt<DIFF>(a0, b0, K_lds, Q_lds, r32, r32, hi);
      qkt<DIFF>(a1, b1, K_lds, Q_lds, r32 + 32, r32, hi);
      SBAR();
      float cb0, cb1;
      if (!DIFF) {
        BIAS_APPLY(t, 0, a0, b0, cb0); BIAS_APPLY(t, 1, a1, b1, cb1);
        float mx = a0[0];
#pragma unroll
        for (int r = 1; r < 16; ++r) mx = fmaxf(mx, a0[r]);
#pragma unroll
        for (int r = 0; r < 16; ++r) mx = fmaxf(mx, a1[r]);
        { auto rr = __builtin_amdgcn_permlane32_swap(__float_as_uint(mx), __float_as_uint(mx), false, false); mx = fmaxf(__uint_as_float(rr[0]), __uint_as_float(rr[1])); }
        const float mn = fmaxf(m1, mx), alpha = __builtin_amdgcn_exp2f((m1 - mn) * C), x1 = -mn * C; m1 = mn;
        float ps = 0.f;
#pragma unroll
        for (int r = 0; r < 16; ++r) { a0[r] = __builtin_amdgcn_exp2f(fmaf(a0[r], C, x1)); ps += a0[r]; }
#pragma unroll
        for (int r = 0; r < 16; ++r) { a1[r] = __builtin_amdgcn_exp2f(fmaf(a1[r], C, x1)); ps += a1[r]; }
        l1 = l1 * alpha + ps;
        if (__any(alpha < 1.0f)) {
          if (hi == 0) wsc[r32] = alpha;
          asm volatile("s_waitcnt lgkmcnt(0)" ::: "memory");
#pragma unroll
          for (int r = 0; r < 16; ++r) { const float al = wsc[crow(r, hi)];
#pragma unroll
            for (int d = 0; d < 4; ++d) o[d][r] *= al; }
        }
        PK4(a0, 0, pa0); PK4(a0, 8, pa1); PK4(a1, 0, pa2); PK4(a1, 8, pa3);
        SBAR();
        pv_step<0>(o, vb0, pa0); pv_step<1>(o, vb0, pa1); pv_step<2>(o, vb0, pa2); pv_step<3>(o, vb0, pa3);
      } else {
      BIAS_APPLY(t, 0, a0, b0, cb0);
      { const float x1 = fmaf(cb0, C, e1), x2 = fmaf(cb0, C, e2);
#pragma unroll
      for (int r = 0; r < 16; ++r) a0[r] = __builtin_amdgcn_exp2f(fmaf(a0[r], C, x1));
      if (DIFF) {
#pragma unroll
        for (int r = 0; r < 16; ++r) a0[r] = fmaf(nsg, __builtin_amdgcn_exp2f(fmaf(b0[r], C, x2)), a0[r]);
      } }
      PK4(a0, 0, pa0); PK4(a0, 8, pa1);
      SBAR();
      pv_step<0>(o, vb0, pa0); pv_step<1>(o, vb0, pa1);
      SBAR();
      BIAS_APPLY(t, 1, a1, b1, cb1);
      { const float x1 = fmaf(cb1, C, e1), x2 = fmaf(cb1, C, e2);
#pragma unroll
      for (int r = 0; r < 16; ++r) a1[r] = __builtin_amdgcn_exp2f(fmaf(a1[r], C, x1));
      if (DIFF) {
#pragma unroll
        for (int r = 0; r < 16; ++r) a1[r] = fmaf(nsg, __builtin_amdgcn_exp2f(fmaf(b1[r], C, x2)), a1[r]);
      } }
      PK4(a1, 0, pa2); PK4(a1, 8, pa3);
      SBAR();
      pv_step<2>(o, vb0, pa2); pv_step<3>(o, vb0, pa3);
      }
#undef PK4

    }
  }
  bf16* Ow = Ob + (size_t)(wid * 32) * 2048;
  if (DIFF) {
    float gsub[4];
#pragma unroll
    for (int d = 0; d < 4; ++d) gsub[d] = subg[32 * d + r32] * 0.8f;
#pragma unroll
    for (int r = 0; r < 16; ++r) {
      float ss = o[0][r] * o[0][r] + o[1][r] * o[1][r] + o[2][r] * o[2][r] + o[3][r] * o[3][r];
      ss += __shfl_xor(ss, 1); ss += __shfl_xor(ss, 2); ss += __shfl_xor(ss, 4); ss += __shfl_xor(ss, 8); ss += __shfl_xor(ss, 16);
      const float rs = 1.0f / sqrtf(ss * (1.0f / 128.0f) + 1e-6f);
      bf16* orow = Ow + (size_t)crow(r, hi) * 2048 + r32;
#pragma unroll
      for (int d = 0; d < 4; ++d) orow[32 * d] = f2bf(o[d][r] * rs * gsub[d]);
      asm volatile("" ::: "memory"); SBAR();
    }
  } else {
    { auto rr = __builtin_amdgcn_permlane32_swap(__float_as_uint(l1), __float_as_uint(l1), false, false); l1 = __uint_as_float(rr[0]) + __uint_as_float(rr[1]); }
    if (hi == 0) wsc[32 + r32] = l1;
    asm volatile("s_waitcnt lgkmcnt(0)" ::: "memory");
#pragma unroll
    for (int r = 0; r < 16; ++r) { bf16* orow = Ow + (size_t)crow(r, hi) * 2048 + r32; const float rl = 1.0f / wsc[32 + crow(r, hi)];
#pragma unroll
      for (int d = 0; d < 4; ++d) orow[32 * d] = f2bf(o[d][r] * rl);
      asm volatile("" ::: "memory"); SBAR(); }
  }
#undef KLOAD
#undef VLOAD
#undef KWRITE
#undef VWRITE
#undef BIAS_APPLY
}
}

typedef unsigned short bf16;
typedef float f32x4 __attribute__((ext_vector_type(4)));
typedef unsigned v4u __attribute__((ext_vector_type(4)));
typedef unsigned v2u __attribute__((ext_vector_type(2)));
typedef short s16x8 __attribute__((ext_vector_type(8)));
#define LAS __attribute__((address_space(3)))
constexpr int NWAVES = 8, NTHR = 512;
constexpr int T_TOK = 49152, TP = 16384, DM = 2048, DFF = 5632;
constexpr size_t MiB = 1u << 20;
constexpr size_t WS_HDN_P = 0, WS_HDN_S = 1 * MiB, WS_SS = 2 * MiB;
constexpr size_t WS_W_ABIN = 4 * MiB, WS_W_ABOUT = 28 * MiB, WS_W_CIN = 36 * MiB, WS_W_COUT = 60 * MiB;
constexpr size_t WS_W_FFIN = 68 * MiB, WS_W_FFOUT = 156 * MiB, WS_W_GATE = 200 * MiB, WS_W_PROJ = 216 * MiB;
constexpr size_t WS_XN = 218 * MiB, WS_Z = 410 * MiB, WS_SSP = 986 * MiB, WS_END = 1000 * MiB;
constexpr int LDS_BYTES = 147456;
constexpr size_t WS_BAR = 3 * MiB + 512 * 1024;
constexpr int LDS_BARST = LDS_BYTES - 64;
constexpr int N_PHASES = 23;

__device__ __forceinline__ unsigned f2bf(float f) { unsigned u = __float_as_uint(f); return (u + 0x7fffu + ((u >> 16) & 1u)) >> 16; }
__device__ __forceinline__ unsigned pk2(float lo, float hi) { return f2bf(lo) | (f2bf(hi) << 16); }
__device__ __forceinline__ float bfl(unsigned w) { return __uint_as_float(w << 16); }
__device__ __forceinline__ float bfh(unsigned w) { return __uint_as_float(w & 0xffff0000u); }
__device__ __forceinline__ float wave_sum(float v) {
#pragma unroll
  for (int o = 1; o < 64; o <<= 1) v += __shfl_xor(v, o);
  return v;
}
__device__ __forceinline__ int ltid() { int t = threadIdx.x; asm volatile("" : "+v"(t)); return t; }
__device__ __forceinline__ int lbid() { int t = blockIdx.x; asm volatile("" : "+s"(t)); return t; }
__device__ __forceinline__ int lgrid() { int t = gridDim.x; asm volatile("" : "+s"(t)); return t; }
struct Args { const float* in[29]; float* out; unsigned char* ws; int ph_lo, ph_hi; };

__device__ __forceinline__ void wt_item(const float* __restrict__ W, int K, int N, bf16* __restrict__ WT, bool ffmap, LAS float* scr, int item, int lane, const float* __restrict__ gain = nullptr) {
  const int nblk = N / 32, kb = item / nblk, nb = item % nblk, k0 = 64 * kb, n0 = 32 * nb;
  int d0 = n0;
  if (ffmap) { const int up = n0 >= DFF ? 1 : 0; const int j = n0 - up * DFF; d0 = 256 * (j >> 7) + 128 * up + (j & 127); }
  {
    const int cc = (lane & 7) * 4; f32x4 v[8]; float gk[8];
#pragma unroll
    for (int i = 0; i < 8; ++i) { const int kk = 8 * i + (lane >> 3); v[i] = *(const f32x4*)(W + (size_t)(k0 + kk) * N + n0 + cc); gk[i] = gain ? gain[k0 + kk] : 1.0f; }
#pragma unroll
    for (int i = 0; i < 8; ++i) { const int kk = 8 * i + (lane >> 3); LAS float* d = scr + kk * 33 + cc; d[0] = v[i][0] * gk[i]; d[1] = v[i][1] * gk[i]; d[2] = v[i][2] * gk[i]; d[3] = v[i][3] * gk[i]; }
  }
  asm volatile("s_waitcnt lgkmcnt(0)" ::: "memory");
  const int c = lane & 7;
#pragma unroll
  for (int j = 0; j < 4; ++j) { const int n = (lane >> 3) + 8 * j; const LAS float* s = scr + (8 * c) * 33 + n;
    v4u o; o.x = pk2(s[0 * 33], s[1 * 33]); o.y = pk2(s[2 * 33], s[3 * 33]); o.z = pk2(s[4 * 33], s[5 * 33]); o.w = pk2(s[6 * 33], s[7 * 33]);
    *(v4u*)(WT + (size_t)(d0 + n) * K + k0 + 8 * c) = o; }
  asm volatile("s_waitcnt lgkmcnt(0)" ::: "memory");
}

__device__ __forceinline__ void rows_in(const float* xin0, const float* xin1, bf16* __restrict__ HB, float* __restrict__ SSx, int gw, int NGW, int lane) {
  for (int m0 = gw * 2; m0 < T_TOK; m0 += NGW * 2) {
    const float* src = m0 < TP ? xin0 + (size_t)m0 * DM : xin1 + (size_t)(m0 - TP) * DM;
    f32x4 v[2][8];
#pragma unroll
    for (int q = 0; q < 2; ++q)
#pragma unroll
      for (int j = 0; j < 8; ++j) v[q][j] = *(const f32x4*)(src + q * DM + 4 * (lane + 64 * j));
#pragma unroll
    for (int q = 0; q < 2; ++q) { float ss = 0.f;
#pragma unroll
      for (int j = 0; j < 8; ++j) { v2u w; w.x = pk2(v[q][j][0], v[q][j][1]); w.y = pk2(v[q][j][2], v[q][j][3]);
        *(v2u*)(HB + (size_t)(m0 + q) * DM + 4 * (lane + 64 * j)) = w;
        const float h0 = bfl(w.x), h1 = bfh(w.x), h2 = bfl(w.y), h3 = bfh(w.y); ss += (h0 * h0 + h1 * h1) + (h2 * h2 + h3 * h3); }
      ss = wave_sum(ss);
      if (lane == 0) SSx[m0 + q] = 1.0f / sqrtf(ss * (1.0f / 2048.0f) + 1e-6f); }
  }
}
__device__ __forceinline__ void rows_out(const bf16* __restrict__ HB, const float* __restrict__ SSf, const float* __restrict__ g, float* __restrict__ out, int gw, int NGW, int lane) {
  f32x4 gv[8];
#pragma unroll
  for (int j = 0; j < 8; ++j) gv[j] = *(const f32x4*)(g + 4 * (lane + 64 * j));
  for (int m0 = gw * 2; m0 < T_TOK; m0 += NGW * 2) {
    v2u w[2][8]; float sp[2];
#pragma unroll
    for (int q = 0; q < 2; ++q) { sp[q] = lane < 32 ? SSf[(size_t)(m0 + q) * 32 + lane] : 0.f;
#pragma unroll
      for (int j = 0; j < 8; ++j) w[q][j] = *(const v2u*)(HB + (size_t)(m0 + q) * DM + 4 * (lane + 64 * j)); }
#pragma unroll
    for (int q = 0; q < 2; ++q) { const float rs = 1.0f / sqrtf(wave_sum(sp[q]) * (1.0f / 2048.0f) + 1e-6f);
#pragma unroll
      for (int j = 0; j < 8; ++j) { f32x4 y; y[0] = bfl(w[q][j].x) * rs * gv[j][0]; y[1] = bfh(w[q][j].x) * rs * gv[j][1]; y[2] = bfl(w[q][j].y) * rs * gv[j][2]; y[3] = bfh(w[q][j].y) * rs * gv[j][3];
        *(f32x4*)(out + (size_t)(m0 + q) * DM + 4 * (lane + 64 * j)) = y; } }
  }
}
__device__ __forceinline__ void rs_rows(const float* __restrict__ SSP, float* __restrict__ RSV, int gw, int NGW, int lane) {
  for (int m = gw; m < T_TOK; m += NGW) {
    float sp = lane < 32 ? SSP[(size_t)m * 32 + lane] : 0.f;
    sp = wave_sum(sp);
    if (lane == 0) RSV[m] = 1.0f / sqrtf(sp * (1.0f / 2048.0f) + 1e-6f);
  }
}

template <class Sched>
__device__ __forceinline__ void rs_panels(const Sched& S, const float* __restrict__ SSP, float* __restrict__ RSV, const int tid) {
  pg8::Unit u; int last = -1;
  for (int i = 0; S.next(i, u); ++i) {
    if (u.pm == last) continue;
    last = u.pm;
    const int row = u.pm * 256 + (tid >> 1);
    const f32x4* p = (const f32x4*)(SSP + (size_t)row * 32 + (tid & 1) * 16);
    const f32x4 a = p[0], b = p[1], c = p[2], d = p[3];
    float sum = (((a[0] + a[1]) + (a[2] + a[3])) + ((b[0] + b[1]) + (b[2] + b[3]))) + (((c[0] + c[1]) + (c[2] + c[3])) + ((d[0] + d[1]) + (d[2] + d[3])));
    sum += __shfl_xor(sum, 1);
    if ((tid & 1) == 0) RSV[row] = 1.0f / sqrtf(sum * (1.0f / 2048.0f) + 1e-6f);
  }
  asm volatile("s_waitcnt vmcnt(0)" ::: "memory");
  __syncthreads();
}

#define PIDX(e) ((e) + ((e) >> 4))
__device__ __forceinline__ float2 cmul(float2 a, float2 b) { return make_float2(a.x * b.x - a.y * b.y, a.x * b.y + a.y * b.x); }
__device__ __forceinline__ constexpr float c16(int j) { return j == 0 ? 1.f : j == 1 ? 0.92387953251f : j == 2 ? 0.70710678119f : j == 3 ? 0.38268343237f : j == 4 ? 0.f : j == 5 ? -0.38268343237f : j == 6 ? -0.70710678119f : -0.92387953251f; }
__device__ __forceinline__ constexpr float s16(int j) { return j == 0 ? 0.f : j == 1 ? 0.38268343237f : j == 2 ? 0.70710678119f : j == 3 ? 0.92387953251f : j == 4 ? 1.f : j == 5 ? 0.92387953251f : j == 6 ? 0.70710678119f : 0.38268343237f; }
template <int LR, bool INV>
__device__ __forceinline__ void fft_stages(float2 (&x)[1 << LR], const int r, const int s) {
  constexpr int R = 1 << LR;
#pragma unroll
  for (int st = 0; st < LR; ++st) {
    const int hl = INV ? (1 << st) : (R >> (st + 1));
    const float fb = (float)r * (0.5f / (float)(hl * s));
    const float2 wb = make_float2(__builtin_amdgcn_cosf(fb), INV ? __builtin_amdgcn_sinf(fb) : -__builtin_amdgcn_sinf(fb));
#pragma unroll
    for (int m = 0; m < R; ++m) {
      if (m & hl) continue;
      const int k = m & (hl - 1); const int j = k * (8 / hl);
      const float2 wc = make_float2(c16(j), INV ? s16(j) : -s16(j));
      const float2 tw = cmul(wb, wc);
      if (!INV) { const float2 p = x[m], q = x[m + hl]; x[m] = make_float2(p.x + q.x, p.y + q.y); x[m + hl] = cmul(make_float2(p.x - q.x, p.y - q.y), tw); }
      else { const float2 p = x[m], q = cmul(x[m + hl], tw); x[m] = make_float2(p.x + q.x, p.y + q.y); x[m + hl] = make_float2(p.x - q.x, p.y - q.y); }
    }
  }
}
template <int LR, bool INV>
__device__ __forceinline__ void fft_pass(float2* X, const int N, const int sl, const int tid) {
  constexpr int R = 1 << LR;
  const int s = 1 << sl;
  for (int g = tid; g < (N >> LR); g += NTHR) {
    const int r = g & (s - 1);
    const int i0 = ((g >> sl) << (sl + LR)) + r;
    float2 x[R];
#pragma unroll
    for (int m = 0; m < R; ++m) x[m] = X[PIDX(i0 + (m << sl))];
    fft_stages<LR, INV>(x, r, s);
#pragma unroll
    for (int m = 0; m < R; ++m) X[PIDX(i0 + (m << sl))] = x[m];
  }
  __syncthreads();
}
template <int LR>
__device__ __forceinline__ void fft_first(float2* X, const bf16* __restrict__ u0, const bf16* __restrict__ u1, const int tid) {
  constexpr int R = 1 << LR;
  float2 x[R];
#pragma unroll
  for (int m = 0; m < R / 2; ++m) x[m] = make_float2(bfl(u0[tid + 512 * m]), bfl(u1[tid + 512 * m]));
#pragma unroll
  for (int m = R / 2; m < R; ++m) x[m] = make_float2(0.f, 0.f);
  fft_stages<LR, false>(x, tid, 512);
#pragma unroll
  for (int m = 0; m < R; ++m) X[PIDX(tid + 512 * m)] = x[m];
  __syncthreads();
}
__device__ __forceinline__ void fft_mid(float2* X, const float2* Hb, const int N, const float invN, const int tid) {
  for (int g = tid; g < (N >> 3); g += NTHR) {
    const int i0 = g << 3; const int p0 = PIDX(i0);
    float2 x[8];
#pragma unroll
    for (int m = 0; m < 8; ++m) x[m] = X[p0 + m];
    fft_stages<3, false>(x, 0, 1);
#pragma unroll
    for (int m = 0; m < 8; ++m) { const float2 h = Hb[p0 + m]; const float2 v = x[m]; x[m] = make_float2((v.x * h.x - v.y * h.y) * invN, (v.x * h.y + v.y * h.x) * invN); }
    fft_stages<3, true>(x, 0, 1);
#pragma unroll
    for (int m = 0; m < 8; ++m) X[p0 + m] = x[m];
  }
  __syncthreads();
}
template <int LR>
__device__ __forceinline__ void fft_last(float2* X, bf16* __restrict__ u0, bf16* __restrict__ u1, const int tid) {
  constexpr int R = 1 << LR;
  float2 x[R];
#pragma unroll
  for (int m = 0; m < R; ++m) x[m] = X[PIDX(tid + 512 * m)];
  fft_stages<LR, true>(x, tid, 512);
#pragma unroll
  for (int m = 0; m < R / 2; ++m) { u0[tid + 512 * m] = (bf16)f2bf(x[m].x); u1[tid + 512 * m] = (bf16)f2bf(x[m].y); }
  __syncthreads();
}
__device__ __forceinline__ void fft_fwd(float2* X, int N, int tid) {
  if (N == 8192) { fft_pass<4, false>(X, N, 9, tid); } else { fft_pass<3, false>(X, N, 9, tid); }
  fft_pass<3, false>(X, N, 6, tid); fft_pass<3, false>(X, N, 3, tid); fft_pass<3, false>(X, N, 0, tid);
}
__device__ __forceinline__ void fft_inv(float2* X, int N, int tid) {
  fft_pass<3, true>(X, N, 0, tid); fft_pass<3, true>(X, N, 3, tid); fft_pass<3, true>(X, N, 6, tid);
  if (N == 8192) { fft_pass<4, true>(X, N, 9, tid); } else { fft_pass<3, true>(X, N, 9, tid); }
}

#define XB_TMO      128
#define XB_XCNT(j)  (256  + 64 * (j))
#define XB_XSUB(j)  (1280 + 64 * (j))
#define XB_XGEN(j)  (2304 + 64 * (j))
#define XB_TOP      3328
#define XB_TOPGEN   3392
#define XCD_BAR_WORDS 3456
#define XB_SPIN_CAP (1u << 18)

__device__ __forceinline__ unsigned xb_ld(unsigned* p)              { return __hip_atomic_load(p, __ATOMIC_RELAXED, __HIP_MEMORY_SCOPE_AGENT); }
__device__ __forceinline__ unsigned xb_add(unsigned* p, unsigned v) { return __hip_atomic_fetch_add(p, v, __ATOMIC_RELAXED, __HIP_MEMORY_SCOPE_AGENT); }
__device__ __forceinline__ unsigned xb_xcc_id() { return (unsigned)__builtin_amdgcn_s_getreg((3 << 11) | 20) & 0xFu; }
#define XB_SPIN(cond, bar) do { unsigned _sp = 0; while (cond) { __builtin_amdgcn_s_sleep(1); \
    if ((++_sp & 255u) == 0u) { if (xb_ld(&(bar)[XB_TMO])) break; if (_sp > XB_SPIN_CAP) { atomicAdd(&(bar)[XB_TMO], 1u); break; } } } } while (0)

struct XcdBarrier {
    unsigned* bar; unsigned x;
    volatile LAS unsigned* st;
};

__device__ __forceinline__ XcdBarrier xcd_barrier_post(unsigned* bar, volatile LAS unsigned* st) {
    XcdBarrier b; b.bar = bar; b.x = xb_xcc_id(); b.st = st;
    if (threadIdx.x == 0) (void)xb_add(&bar[XB_XCNT(b.x)], 1u);
    return b;
}
__device__ __forceinline__ void xcd_barrier_complete(unsigned* bar, unsigned x, unsigned& nloc, unsigned& nx) {
    const unsigned G = gridDim.x * gridDim.y * gridDim.z;
    unsigned sum, cnt, mine, sp = 0u;
    for (;;) {
        sum = 0u; cnt = 0u; mine = 0u;
#pragma unroll
        for (unsigned j = 0; j < 16; ++j) { const unsigned c = xb_ld(&bar[XB_XCNT(j)]); sum += c; cnt += (c > 0u) ? 1u : 0u; mine = (j == x) ? c : mine; }
        if (sum == G) break;
        __builtin_amdgcn_s_sleep(1);
        if ((++sp & 255u) == 0u) { if (xb_ld(&bar[XB_TMO])) break; if (sp > XB_SPIN_CAP) { atomicAdd(&bar[XB_TMO], 1u); break; } }
    }
    nloc = mine > 0u ? mine : 1u; nx = cnt > 0u ? cnt : 1u;
}

__device__ __forceinline__ void xcd_barrier(const XcdBarrier& b) {
    asm volatile("s_waitcnt vmcnt(0)" ::: "memory");
    __syncthreads();
    if (threadIdx.x == 0) {
        unsigned* bar = b.bar;
        __builtin_amdgcn_s_waitcnt(0);
        unsigned nloc = b.st[0], nx = b.st[1];
        if (nloc == 0u) { xcd_barrier_complete(bar, b.x, nloc, nx); b.st[0] = nloc; b.st[1] = nx; }
        const unsigned old = xb_add(&bar[XB_XSUB(b.x)], 1u);
        const unsigned gen = old / nloc;
        if (old + 1u == (gen + 1u) * nloc) {
            __builtin_amdgcn_fence(__ATOMIC_RELEASE, "agent");
            asm volatile("s_waitcnt vmcnt(0)" ::: "memory");
            const unsigned og = xb_add(&bar[XB_TOP], 1u);
            const unsigned tg = og / nx;
            if (og + 1u == (tg + 1u) * nx) xb_add(&bar[XB_TOPGEN], 1u);
            else XB_SPIN(xb_ld(&bar[XB_TOPGEN]) == tg, bar);
            __builtin_amdgcn_fence(__ATOMIC_ACQUIRE, "agent");
            xb_add(&bar[XB_XGEN(b.x)], 1u);
            asm volatile("s_waitcnt vmcnt(0)" ::: "memory");
        } else {
            XB_SPIN(xb_ld(&bar[XB_XGEN(b.x)]) == gen, bar);
            __builtin_amdgcn_fence(__ATOMIC_ACQUIRE, "agent");
            asm volatile("s_waitcnt vmcnt(0)" ::: "memory");
        }
    }
    __syncthreads();
}

#define CAS __attribute__((address_space(4)))
__device__ __forceinline__ const void* ldarg(int i) {
  CAS const char* kp = (CAS const char*)__builtin_amdgcn_kernarg_segment_ptr();
  asm volatile("" : "+s"(kp));
  typedef const void* cvp_t;
  const void* p = *(CAS const cvp_t*)(kp + 8 * i);
  return (const void*)(__attribute__((address_space(1))) const char*)p;
}
__device__ __forceinline__ int ldint(int off) {
  CAS const char* kp = (CAS const char*)__builtin_amdgcn_kernarg_segment_ptr();
  asm volatile("" : "+s"(kp));
  return *(CAS const int*)(kp + off);
}
#define AIN(i) ((const float*)ldarg(i))
#define AOUT ((float*)ldarg(29))
#define AWS ((unsigned char*)ldarg(30))
__global__ void __launch_bounds__(NTHR, 2) mega_fwd(Args a_unused) {
  extern __shared__ __attribute__((aligned(16))) unsigned char lds[];
  cg::grid_group grid = cg::this_grid();
#define tid ltid()
#define lane (ltid() & 63)
#define wave __builtin_amdgcn_readfirstlane(ltid() >> 6)
#define G lgrid()
#define bx lbid()
#ifdef ONLY_PHASE
#define IN(k) ((k) == ONLY_PHASE)
#else
#ifndef SKIP_MASK
#define SKIP_MASK 0u
#endif
#define IN(k) (ldint(248) <= (k) && (k) < ldint(252) && !((SKIP_MASK >> (k)) & 1u))
#endif
#define INR(k) (ldint(248) <= (k) && (k) < ldint(252))
#define SEAM(k) do { if (INR(k) && INR((k) + 1)) { if ((k) == 0) grid.sync(); else xcd_barrier(xbar); } } while (0)
#define GEMM_LDS ((LAS unsigned char*)lds)
#define ws AWS
#define XN ((bf16*)(ws + WS_XN))
#define Z ((bf16*)(ws + WS_Z))

  volatile LAS unsigned* barst = (volatile LAS unsigned*)((LAS unsigned char*)lds + LDS_BARST);
  if (ltid() < 2) barst[ltid()] = 0u;
  __syncthreads();
  XcdBarrier xbar; xbar.bar = (unsigned*)(ws + WS_BAR); xbar.x = 0; xbar.st = barst;
  if (IN(0)) {
    if (bx == 0) { unsigned* bw = (unsigned*)(ws + WS_BAR); for (int i = tid; i < XCD_BAR_WORDS; i += NTHR) bw[i] = 0u; }
    LAS float* scr = (LAS float*)((LAS unsigned char*)lds + wave * 16384);
    const int gw = bx * NWAVES + wave, NGW = G * NWAVES;
    constexpr int I_IN = 32 * 192, I_OUT = 32 * 64, I_FI = 32 * 352, I_FO = 88 * 64, I_PJ = 4 * 64;
    constexpr int NITEMS = 2 * I_IN + 2 * I_OUT + 2 * I_FI + 2 * I_FO + 2 * I_OUT + 2 * I_PJ;
    for (int it = gw; it < NITEMS; it += NGW) {
      int r = it;
      if (r < I_IN) { wt_item(AIN(9), 2048, 6144, (bf16*)(ws + WS_W_ABIN), false, scr, r, lane, AIN(5)); continue; } r -= I_IN;
      if (r < I_IN) { wt_item(AIN(14), 2048, 6144, (bf16*)(ws + WS_W_CIN), false, scr, r, lane, AIN(5) + 2048); continue; } r -= I_IN;
      if (r < I_OUT) { wt_item(AIN(10), 2048, 2048, (bf16*)(ws + WS_W_ABOUT), false, scr, r, lane); continue; } r -= I_OUT;
      if (r < I_OUT) { wt_item(AIN(24), 2048, 2048, (bf16*)(ws + WS_W_COUT), false, scr, r, lane); continue; } r -= I_OUT;
      if (r < 2 * I_FI) { const int l = r / I_FI; wt_item(AIN(25) + (size_t)l * 2048 * 11264, 2048, 11264, (bf16*)(ws + WS_W_FFIN) + (size_t)l * 11264 * 2048, true, scr, r % I_FI, lane, AIN(6) + l * 2048); continue; } r -= 2 * I_FI;
      if (r < 2 * I_FO) { const int l = r / I_FO; wt_item(AIN(26) + (size_t)l * 5632 * 2048, 5632, 2048, (bf16*)(ws + WS_W_FFOUT) + (size_t)l * 2048 * 5632, false, scr, r % I_FO, lane); continue; } r -= 2 * I_FO;
      if (r < 2 * I_OUT) { const int l = r / I_OUT; wt_item(AIN(28) + (size_t)l * 2048 * 2048, 2048, 2048, (bf16*)(ws + WS_W_GATE) + (size_t)l * 2048 * 2048, false, scr, r % I_OUT, lane, AIN(7) + l * 2048); continue; } r -= 2 * I_OUT;
      { const int l = r / I_PJ; wt_item(AIN(27) + (size_t)l * 256 * 2048, 256, 2048, (bf16*)(ws + WS_W_PROJ) + (size_t)l * 2048 * 256, false, scr, r % I_PJ, lane); }
    }
    rows_in(AIN(0), AIN(1), XN, (float*)(ws + WS_SS), gw, NGW, lane);
    { bf16* PbA = (bf16*)((char*)AOUT + 288 * MiB);
      for (int r0 = gw * 4; r0 < 2 * T_TOK; r0 += NGW * 4) {
        const int ly = r0 >= T_TOK ? 1 : 0, m0 = r0 - ly * T_TOK;
        const float* src = m0 < TP ? AIN(2) + (size_t)ly * TP * 256 + (size_t)m0 * 256 : AIN(3) + (size_t)ly * (T_TOK - TP) * 256 + (size_t)(m0 - TP) * 256;
        f32x4 v[4];
#pragma unroll
        for (int q = 0; q < 4; ++q) v[q] = *(const f32x4*)(src + q * 256 + 4 * lane);
#pragma unroll
        for (int q = 0; q < 4; ++q) { v2u w; w.x = pk2(v[q][0], v[q][1]); w.y = pk2(v[q][2], v[q][3]); *(v2u*)(PbA + (size_t)(r0 + q) * 256 + 4 * lane) = w; }
      } }
    for (int row = gw; row < 2048 + 4096; row += NGW) {
      const int gsel = row >= 2048 ? 1 : 0; const int L = gsel ? 4096 : 2048; const int t = row - (gsel ? 2048 : 0);
      float* hd = (float*)(ws + (gsel ? WS_HDN_S : WS_HDN_P));
      const float tl = (float)t / (float)(L - 1);
      const float wt = (6.2831855f * (float)t) / (float)L;
      float feat = 0.f;
      if (lane == 0) feat = tl;
      else if (lane <= 32) { const int k = (lane - 1) & 15; const float fk = 1e-4f + (float)k * ((15.0f - 1e-4f) / 15.0f); const float ang = wt * fk; feat = lane <= 16 ? cosf(ang) : -sinf(ang); }
      const float* w1 = AIN(17); const float* b1 = AIN(18); const float* fr = AIN(19); const float* w2 = AIN(20); const float* b2 = AIN(21);
      float acc = b1[lane];
      for (int i = 0; i < 33; ++i) acc += __shfl(feat, i) * w1[i * 64 + lane];
      const float h1 = sinf(fr[lane] * acc);
      float acc2 = b2[lane];
      for (int i = 0; i < 64; ++i) acc2 += __shfl(h1, i) * w2[i * 64 + lane];
      hd[(size_t)lane * L + t] = sinf(fr[64 + lane] * acc2);
    }
  }
  SEAM(0);
  if (INR(0) && INR(1)) xbar = xcd_barrier_post((unsigned*)(ws + WS_BAR), barst);

  if (IN(1)) {
    pg8::Gemm g{XN, (const bf16*)(ws + WS_W_ABIN), T_TOK, 6144, 2048}; pg8::StaticOrder S; S.init(T_TOK, 6144, G, bx);
    pg8::EpiSplit<true> E{Z, 1024, 1024, (size_t)T_TOK * 1024, (const float*)(ws + WS_SS)};
    pg8::gemm_phase<pg8::EpiSplit<true>, pg8::StaticOrder, true, true>(GEMM_LDS, g, S, E);
  }
  SEAM(1);

  if (IN(2)) {
    const size_t ZS = (size_t)T_TOK * 1024;
    const bf16 *QA = Z, *KA = Z + ZS, *VA = Z + 2 * ZS, *QB = Z + 3 * ZS, *KB = Z + 4 * ZS, *VB = Z + 5 * ZS;
    bf16* O = (bf16*)AOUT;
    {
      float* FT = (float*)((char*)AOUT + 192 * MiB);
      float* wsm = (float*)lds;
      const float* w3 = AIN(22); const float* skip = AIN(23);
#pragma unroll 1
      for (int it = bx; it < 3072; it += G) {
        int gsel, cb8, tb;
        if (it < 2048) { gsel = 1; cb8 = it >> 3; tb = it & 7; } else { gsel = 0; const int v = it - 2048; cb8 = v >> 2; tb = v & 3; }
        const int L = gsel ? 4096 : 2048, N = 2 * L, t = tb * NTHR + tid;
        const float* hd = (const float*)(ws + (gsel ? WS_HDN_S : WS_HDN_P));
        __syncthreads();
        for (int q = tid; q < 1024; q += NTHR) { const int j = q >> 6, i = q & 63; wsm[q] = w3[(size_t)i * 4096 + (j < 8 ? cb8 * 8 + j : 2048 + cb8 * 8 + (j - 8))]; }
        __syncthreads();
        float x[64];
#pragma unroll
        for (int i = 0; i < 64; ++i) x[i] = hd[(size_t)i * L + t];
        const float tl = (float)t / (float)(L - 1);
        float* FTg = FT + (gsel ? (size_t)0 : (size_t)2048 * 8192);
#pragma unroll 1
        for (int j = 0; j < 8; ++j) {
          const int c = cb8 * 8 + j; float hf = 0.f, hb = 0.f;
#pragma unroll
          for (int i = 0; i < 64; i += 4) { const f32x4 wf = *(const f32x4*)(wsm + j * 64 + i), wb = *(const f32x4*)(wsm + (8 + j) * 64 + i);
            hf = fmaf(x[i], wf[0], hf); hf = fmaf(x[i + 1], wf[1], hf); hf = fmaf(x[i + 2], wf[2], hf); hf = fmaf(x[i + 3], wf[3], hf);
            hb = fmaf(x[i], wb[0], hb); hb = fmaf(x[i + 1], wb[1], hb); hb = fmaf(x[i + 2], wb[2], hb); hb = fmaf(x[i + 3], wb[3], hb); }
          const float delta = fabsf(-15.350567f + (float)c * ((-3.0701134f + 15.350567f) / 2047.0f));
          const float dec = expf(-tl * delta);
          hf *= dec; hb *= dec;
          float* row = FTg + (size_t)c * N;
          if (t == 0) { hf += skip[c]; row[L] = 0.f; }
          row[t] = hf;
          if (t >= 1) row[N - t] = hb;
        }
      }
    }
    const int vcu = (G % 8 == 0) ? (bx % 8) * (G / 8) + bx / 8 : bx;
    float lam;
    { const float* lv = AIN(11); const float s1 = wave_sum(lv[lane] * lv[64 + lane]), s2 = wave_sum(lv[128 + lane] * lv[192 + lane]); lam = expf(s1) - expf(s2) + 0.2f; }
#ifndef NO_DIFF
#pragma unroll 1
    for (int u = vcu; u < 1536; u += G) {
      int s, h, qb, L;
      if (u < 1024) { qb = u & 15; const int bh = u >> 4; h = bh & 7; s = 8 + (bh >> 3); L = 4096; }
      else { const int v = u - 1024; qb = v & 7; const int bh = v >> 3; h = bh & 7; s = bh >> 3; L = 2048; }
      const size_t mbase = s < 8 ? (size_t)s * 2048 : (size_t)TP + (size_t)(s - 8) * 4096;
      att::attn_unit<true>(QA + (mbase + 256 * qb) * 1024 + 128 * h, KA + mbase * 1024 + 128 * h, VA + mbase * 1024 + 128 * h,
                           O + (mbase + 256 * qb) * 2048 + 128 * h, 0, L / 64, 256 * qb, 0, lam, AIN(4), h, AIN(12), (char*)lds);
    }
#endif
#ifndef NO_NA
#pragma unroll 1
    for (int v = vcu; v < 1536; v += G) {
      int s, h, rb, rows;
      if (v < 1024) { rb = v & 15; const int bh = v >> 4; h = bh & 7; s = 8 + (bh >> 3); rows = 64; }
      else { const int w = v - 1024; rb = w & 7; const int bh = w >> 3; h = bh & 7; s = bh >> 3; rows = 32; }
      const size_t mbase = s < 8 ? (size_t)s * 2048 : (size_t)TP + (size_t)(s - 8) * 4096;
      int tl = 4 * rb - 4; tl = tl < 0 ? 0 : (tl > rows - 8 ? rows - 8 : tl);
      int th = 4 * rb + 3 - 4; th = th < 0 ? 0 : (th > rows - 8 ? rows - 8 : th); th += 8;
      att::attn_unit<false>(QB + (mbase + 256 * rb) * 1024 + 128 * h, KB + mbase * 1024 + 128 * h, VB + mbase * 1024 + 128 * h,
                            O + (mbase + 256 * rb) * 2048 + 1024 + 128 * h, tl, th, 4 * rb, rows, 0.f, AIN(13), h, nullptr, (char*)lds);
    }
#endif
    __syncthreads();
  }
  SEAM(2);

#pragma unroll
  for (int layer = 0; layer < 2; ++layer) {
    const int pb = layer == 0 ? 3 : 15;
    if (layer == 1) {
      if (IN(11)) {
        pg8::Gemm g{XN, (const bf16*)(ws + WS_W_CIN), T_TOK, 6144, 2048}; pg8::StaticOrder S; S.init(T_TOK, 6144, G, bx);
        rs_panels(S, (const float*)(ws + WS_SSP) + (size_t)T_TOK * 32, (float*)(ws + WS_SS) + 3 * T_TOK, tid);
        pg8::EpiSplit<true> E{Z, 2048, 2048, (size_t)T_TOK * 2048, (const float*)(ws + WS_SS) + 3 * T_TOK};
        pg8::gemm_phase<pg8::EpiSplit<true>, pg8::StaticOrder, true, true>(GEMM_LDS, g, S, E);
      }
      SEAM(11);
      constexpr size_t ZS = (size_t)T_TOK * 2048;
      if (IN(12)) {
        bf16* ut = (bf16*)lds;
        const bf16* Z1 = Z + ZS; const bf16* Z2 = Z + 2 * ZS; bf16* UT = (bf16*)AOUT; const float* cw = AIN(15); const float* cb = AIN(16);
        for (int it = bx; it < 768 * 32; it += G) {
          const int ct = it & 31, tt = it >> 5;
          const int tok = tid >> 3, cgp = tid & 7, m = tt * 64 + tok, c = ct * 64 + cgp * 8;
          const int L = m < TP ? 2048 : 4096; const int pos = m < TP ? (m & 2047) : ((m - TP) & 4095);
          const bool hp = pos > 0, hn = pos < L - 1;
          const s16x8 zero = {0, 0, 0, 0, 0, 0, 0, 0};
          const s16x8 x1p = hp ? *(const s16x8*)(Z1 + (size_t)(m - 1) * 2048 + c) : zero, x1c = *(const s16x8*)(Z1 + (size_t)m * 2048 + c), x1n = hn ? *(const s16x8*)(Z1 + (size_t)(m + 1) * 2048 + c) : zero;
          const s16x8 vp = hp ? *(const s16x8*)(Z2 + (size_t)(m - 1) * 2048 + c) : zero, vc = *(const s16x8*)(Z2 + (size_t)m * 2048 + c), vn = hn ? *(const s16x8*)(Z2 + (size_t)(m + 1) * 2048 + c) : zero;
          __syncthreads();
          f32x4 wa[4][2], wv[4][2];
#pragma unroll
          for (int k = 0; k < 3; ++k)
#pragma unroll
            for (int q = 0; q < 2; ++q) { wa[k][q] = *(const f32x4*)(cw + k * 6144 + 2048 + c + 4 * q); wv[k][q] = *(const f32x4*)(cw + k * 6144 + 4096 + c + 4 * q); }
#pragma unroll
          for (int q = 0; q < 2; ++q) { wa[3][q] = *(const f32x4*)(cb + 2048 + c + 4 * q); wv[3][q] = *(const f32x4*)(cb + 4096 + c + 4 * q); }
#pragma unroll
          for (int e = 0; e < 8; ++e) {
            const float x1 = wa[0][e >> 2][e & 3] * bfl((unsigned short)x1p[e]) + wa[1][e >> 2][e & 3] * bfl((unsigned short)x1c[e]) + wa[2][e >> 2][e & 3] * bfl((unsigned short)x1n[e]) + wa[3][e >> 2][e & 3];
            const float vv = wv[0][e >> 2][e & 3] * bfl((unsigned short)vp[e]) + wv[1][e >> 2][e & 3] * bfl((unsigned short)vc[e]) + wv[2][e >> 2][e & 3] * bfl((unsigned short)vn[e]) + wv[3][e >> 2][e & 3];
            ut[(cgp * 8 + e) * 72 + tok] = (bf16)f2bf(vv * x1);
          }
          __syncthreads();
          { const int ch = tid >> 3, chunk = tid & 7;
            *(v4u*)(UT + (size_t)(ct * 64 + ch) * T_TOK + tt * 64 + chunk * 8) = *(const v4u*)(ut + ch * 72 + chunk * 8); }
        }
        __syncthreads();
      }
      SEAM(12);
      if (IN(13)) {
        float2* A = (float2*)lds; float2* Hb = (float2*)(lds + 69632); float* wsm = (float*)(lds + 139264); bf16* UT = (bf16*)AOUT;
        const float* w3 = AIN(22); const float* skip = AIN(23);
#pragma unroll 1
        for (int u = bx; u < 4096; u += G) {
          const int gsel = u < 2048 ? 1 : 0, c = u & 2047;
          const int L = gsel ? 4096 : 2048, N = 2 * L;
          const float* hd = (const float*)(ws + (gsel ? WS_HDN_S : WS_HDN_P));
          __syncthreads();
          { const float* frow = (const float*)((const char*)AOUT + 192 * MiB) + (gsel ? (size_t)c * 8192 : (size_t)2048 * 8192 + (size_t)c * 4096);
            for (int n = tid; n < N; n += NTHR) Hb[PIDX(n)] = make_float2(frow[n], 0.f); }
          __syncthreads();
          fft_fwd(Hb, N, tid);
          const float invN = 1.0f / (float)N;
          const size_t sbase = gsel ? (size_t)TP : 0;
          bf16* urow = UT + (size_t)c * T_TOK + sbase;
#pragma unroll 1
          for (int pr = 0; pr < 4; ++pr) {
            bf16* u0 = urow + (size_t)(2 * pr) * L; bf16* u1 = u0 + L;
            if (gsel) fft_first<4>(A, u0, u1, tid); else fft_first<3>(A, u0, u1, tid);
            fft_pass<3, false>(A, N, 6, tid); fft_pass<3, false>(A, N, 3, tid);
            fft_mid(A, Hb, N, invN, tid);
            fft_pass<3, true>(A, N, 3, tid); fft_pass<3, true>(A, N, 6, tid);
            if (gsel) fft_last<4>(A, u0, u1, tid); else fft_last<3>(A, u0, u1, tid);
          }
        }
        __syncthreads();
      }
      SEAM(13);
      if (IN(14)) {
        bf16* yt = (bf16*)lds; bf16* O = Z + ZS; const bf16* Z0 = Z; const bf16* UT = (const bf16*)AOUT; const float* cw = AIN(15); const float* cb = AIN(16);
        for (int it = bx; it < 768 * 32; it += G) {
          const int ct = it & 31, tt = it >> 5;
          __syncthreads();
          { const int ch = tid >> 3, chunk = tid & 7;
            *(v4u*)(yt + ch * 72 + chunk * 8) = *(const v4u*)(UT + (size_t)(ct * 64 + ch) * T_TOK + tt * 64 + chunk * 8); }
          const int tok = tid >> 3, cgp = tid & 7, m = tt * 64 + tok, c = ct * 64 + cgp * 8;
          const int L = m < TP ? 2048 : 4096; const int pos = m < TP ? (m & 2047) : ((m - TP) & 4095);
          const bool hp = pos > 0, hn = pos < L - 1;
          const s16x8 zero = {0, 0, 0, 0, 0, 0, 0, 0};
          const s16x8 xp = hp ? *(const s16x8*)(Z0 + (size_t)(m - 1) * 2048 + c) : zero, xc = *(const s16x8*)(Z0 + (size_t)m * 2048 + c), xn = hn ? *(const s16x8*)(Z0 + (size_t)(m + 1) * 2048 + c) : zero;
          __syncthreads();
          float o[8];
          f32x4 wx[4][2];
#pragma unroll
          for (int k = 0; k < 3; ++k)
#pragma unroll
            for (int q = 0; q < 2; ++q) wx[k][q] = *(const f32x4*)(cw + k * 6144 + c + 4 * q);
#pragma unroll
          for (int q = 0; q < 2; ++q) wx[3][q] = *(const f32x4*)(cb + c + 4 * q);
#pragma unroll
          for (int e = 0; e < 8; ++e) {
            const float x0 = wx[0][e >> 2][e & 3] * bfl((unsigned short)xp[e]) + wx[1][e >> 2][e & 3] * bfl((unsigned short)xc[e]) + wx[2][e >> 2][e & 3] * bfl((unsigned short)xn[e]) + wx[3][e >> 2][e & 3];
            o[e] = bfl(yt[(cgp * 8 + e) * 72 + tok]) * x0;
          }
          v4u w; w.x = pk2(o[0], o[1]); w.y = pk2(o[2], o[3]); w.z = pk2(o[4], o[5]); w.w = pk2(o[6], o[7]);
          *(v4u*)(O + (size_t)m * 2048 + c) = w;
        }
        __syncthreads();
      }
      SEAM(14);
    }
    float* const SSb = (float*)(ws + WS_SSP);
    constexpr size_t SSN = (size_t)T_TOK * 32;
    if (IN(pb)) {
      const bf16* Oin = layer == 0 ? (const bf16*)AOUT : Z + (size_t)T_TOK * 2048;
      pg8::Gemm g{Oin, (const bf16*)(ws + (layer == 0 ? WS_W_ABOUT : WS_W_COUT)), T_TOK, 2048, 2048}; pg8::StaticOrder S; S.init(T_TOK, 2048, G, bx);
      pg8::EpiResAddB E{XN, 2048, SSb + (layer == 0 ? 1 : 0) * SSN}; pg8::gemm_phase<pg8::EpiResAddB, pg8::StaticOrder, true, true>(GEMM_LDS, g, S, E);
    }
    SEAM(pb);
    float* const RSb = (float*)(ws + WS_SS);
    if (IN(pb + 2)) {
      pg8::Gemm g{XN, (const bf16*)(ws + WS_W_FFIN) + (size_t)layer * 11264 * 2048, T_TOK, 11264, 2048}; pg8::StaticOrder S; S.init(T_TOK, 11264, G, bx);
      rs_panels(S, SSb + (layer == 0 ? 1 : 0) * SSN, RSb + (layer == 0 ? 1 : 4) * T_TOK, tid);
      pg8::EpiSwiGLU<true> E{Z, DFF, RSb + (layer == 0 ? 1 : 4) * T_TOK}; pg8::gemm_phase<pg8::EpiSwiGLU<true>, pg8::StaticOrder, true, true>(GEMM_LDS, g, S, E);
    }
    SEAM(pb + 2);
    if (IN(pb + 3)) {
      pg8::Gemm g{Z, (const bf16*)(ws + WS_W_FFOUT) + (size_t)layer * 2048 * 5632, T_TOK, 2048, DFF}; pg8::StaticOrder S; S.init(T_TOK, 2048, G, bx);
      pg8::EpiResAddB E{XN, 2048, SSb + (layer == 0 ? 0 : 1) * SSN};
      pg8::gemm_phase<pg8::EpiResAddB, pg8::StaticOrder, true, true>(GEMM_LDS, g, S, E);
    }
    SEAM(pb + 3);
    if (IN(pb + 5)) {
      pg8::Gemm g{XN, (const bf16*)(ws + WS_W_GATE) + (size_t)layer * 2048 * 2048, T_TOK, 2048, 2048}; pg8::StaticOrder S; S.init(T_TOK, 2048, G, bx);
      rs_panels(S, SSb + (layer == 0 ? 0 : 1) * SSN, RSb + (layer == 0 ? 2 : 5) * T_TOK, tid);
      pg8::EpiSigmoid<true> E{Z, 2048, RSb + (layer == 0 ? 2 : 5) * T_TOK};
      pg8::gemm_phase<pg8::EpiSigmoid<true>, pg8::StaticOrder, true, true>(GEMM_LDS, g, S, E);
    }
    SEAM(pb + 5);
    if (IN(pb + 6)) {
      const bf16* Pb = (const bf16*)((const char*)AOUT + 288 * MiB) + (size_t)layer * T_TOK * 256; const bf16* Gt = Z;
      pg8::Gemm g{Pb, (const bf16*)(ws + WS_W_PROJ) + (size_t)layer * 2048 * 256, T_TOK, 2048, 256}; pg8::StaticOrder S; S.init(T_TOK, 2048, G, bx);
      pg8::EpiGateResB E{XN, Gt, 2048, SSb + (layer == 0 ? 1 : 0) * SSN}; pg8::gemm_phase<pg8::EpiGateResB, pg8::StaticOrder, true, true>(GEMM_LDS, g, S, E);
    }
    SEAM(pb + 6);
    if (layer == 1) { if (IN(pb + 7)) rows_out(XN, SSb, AIN(8), AOUT, bx * NWAVES + wave, G * NWAVES, lane); }
  }
#undef IN
#undef SEAM
#undef tid
#undef lane
#undef wave
#undef G
#undef bx
#undef ws
#undef XN
#undef Z
}

#ifndef MK_MULTI
#define MK_MULTI 0
#endif
extern "C" void kernel_launch(void* const* d_in, const int* in_sizes, int n_in, void* d_out, int out_size, void* d_ws, size_t ws_size, hipStream_t stream) {
  static int grid = 0;
  if (grid == 0) {
    if (n_in != 29 || out_size != T_TOK * DM || ws_size < WS_END) { fprintf(stderr, "kernel_launch: unexpected shapes n_in %d out %d ws %zu (need %zu)\n", n_in, out_size, ws_size, (size_t)WS_END); grid = -1; return; }
    int dev = 0, cus = 0, per_cu = 0;
    hipGetDevice(&dev); hipDeviceGetAttribute(&cus, hipDeviceAttributeMultiprocessorCount, dev);
    if (hipFuncSetAttribute((const void*)mega_fwd, hipFuncAttributeMaxDynamicSharedMemorySize, LDS_BYTES) != hipSuccess) { fprintf(stderr, "kernel_launch: hipFuncSetAttribute failed\n"); grid = -1; return; }
    hipOccupancyMaxActiveBlocksPerMultiprocessor(&per_cu, (const void*)mega_fwd, NTHR, LDS_BYTES);
    (void)hipGetLastError();
    if (per_cu < 1) per_cu = 1;
    grid = cus * 1;
    fprintf(stderr, "kernel_launch: cus %d per_cu %d grid %d\n", cus, per_cu, grid);
  }
  if (grid < 0) return;
  Args a{};
  for (int i = 0; i < 29; ++i) a.in[i] = (const float*)d_in[i];
  a.out = (float*)d_out; a.ws = (unsigned char*)d_ws;
#if MK_MULTI
  for (int p = 0; p < N_PHASES; ++p) { a.ph_lo = p; a.ph_hi = p + 1; hipLaunchKernelGGL(mega_fwd, dim3(grid), dim3(NTHR), LDS_BYTES, stream, a); }
#else
  a.ph_lo = 0; a.ph_hi = N_PHASES;
  void* kargs[] = {&a};
  hipError_t e = hipLaunchCooperativeKernel((const void*)mega_fwd, dim3(grid), dim3(NTHR), kargs, LDS_BYTES, stream);
  if (e != hipSuccess) fprintf(stderr, "kernel_launch: cooperative launch failed: %s (grid %d)\n", hipGetErrorString(e), grid);
#endif
}
```

```cpp
#include <hip/hip_runtime.h>
#include <hip/hip_cooperative_groups.h>
#include <cstdio>
#include <cstdint>
namespace cg = cooperative_groups;
namespace pg8 {
#define PG8_LAS __attribute__((address_space(3)))
typedef unsigned short bf16_t;
typedef short bf16x8 __attribute__((ext_vector_type(8)));
typedef float f32x4 __attribute__((ext_vector_type(4)));
typedef unsigned u32x4 __attribute__((ext_vector_type(4)));
constexpr int BM = 256, BK = 64, HALF = 128, HTB = HALF * BK * 2  , STAGE_BYTES = 8 * HTB, NXCD = 8;

__host__ __device__ __forceinline__ int lds_byte(int r, int c) { const int st = (r >> 4) * 2 + (c >> 5), rr = r & 15, cc = c & 31, ob = rr * 64 + cc * 2; return st * 1024 + (ob ^ (((ob >> 9) & 1) << 5)); }
__host__ __device__ __forceinline__ void stage_rc(int b, int& R, int& C) { const int st = b / 1024, sb = b % 1024, swz = sb ^ (((sb >> 9) & 1) << 5); R = (st >> 1) * 16 + swz / 64; C = (st & 1) * 32 + (swz % 64) / 2; }
__host__ __device__ __forceinline__ int perm32(int rho) { const int n = rho >> 4, i = rho & 15; return 8 * (i >> 2) + 4 * n + (i & 3); }

struct Unit { int pm, pn; };
struct Gemm { const bf16_t* A; const bf16_t* Bt; int M, N, K; };

struct StaticOrder {
    int nM, nN, nwg, G, c, WGM;
    __host__ __device__ void init(int M, int N, int G_, int c_, int wgm_ = 4) { nM = M / BM; nN = N / BM; nwg = nM * nN; G = G_; c = c_; WGM = wgm_; }
    __host__ __device__ bool next(int i, Unit& u) const {
        const long L = (long)i * G + c; if (L >= nwg) return false;
        int wgid = (int)L; { const int q = nwg / NXCD, r = nwg % NXCD, xcd = wgid % NXCD, off = wgid / NXCD; wgid = (xcd < r ? xcd * (q + 1) : r * (q + 1) + (xcd - r) * q) + off; }
        const int nig = WGM * nN, gid = wgid / nig, fm = gid * WGM, gsz = (nM - fm) < WGM ? (nM - fm) : WGM;
        u.pm = fm + ((wgid % nig) % gsz); u.pn = (wgid % nig) / gsz; return true;
    }
    __device__ __forceinline__ void a_ready(const Unit&) const {}
    __device__ __forceinline__ void done(const Unit&) const {}
};

typedef float f32x2c_t __attribute__((ext_vector_type(2))); typedef __bf16 bf16x2c_t __attribute__((ext_vector_type(2)));
__device__ __forceinline__ unsigned cvt_pk_bf16(float lo, float hi) { f32x2c_t v = {lo, hi}; bf16x2c_t b = __builtin_convertvector(v, bf16x2c_t); return __builtin_bit_cast(unsigned, b); }
typedef float f32x2 __attribute__((ext_vector_type(2)));
__device__ __forceinline__ float bf2f(unsigned short b) { return __uint_as_float(((unsigned)b) << 16); }
__device__ __forceinline__ float rs_of(const float* RSV, int row) { return RSV[row]; }
template <bool RS> struct EpiSplit {
    static constexpr bool PERM = true, AFTER_DRAIN = false;
    bf16_t* O; int ldc; int split_cols; size_t split_stride; const float* SS;
    __device__ __forceinline__ void operator()(const f32x4 (&acc)[2][2][4][2], const Unit& u, int wr, int wc, int fr, int fq) const {
        const int row0 = u.pm * BM + wr * 64 + fr; int colt = u.pn * BM; bf16_t* base = O;
        { const int t = colt / split_cols; base += (size_t)t * split_stride; colt -= t * split_cols; }
        const int col0 = colt + wc * 32 + 8 * fq;
        float rsv[2][4];
#pragma unroll
        for (int ai = 0; ai < 2; ++ai)
#pragma unroll
            for (int m = 0; m < 4; ++m) rsv[ai][m] = RS ? rs_of(SS, row0 + ai * HALF + m * 16) : 1.0f;
#pragma unroll
        for (int ai = 0; ai < 2; ++ai)
#pragma unroll
            for (int m = 0; m < 4; ++m) { bf16_t* rowp = base + (size_t)(row0 + ai * HALF + m * 16) * ldc + col0;
                const float rs = rsv[ai][m];
#pragma unroll
                for (int bj = 0; bj < 2; ++bj) { f32x4 v0 = acc[ai][bj][m][0], v1 = acc[ai][bj][m][1];
                    if (RS) { v0 = v0 * rs; v1 = v1 * rs; }
                    u32x4 w; w.x = cvt_pk_bf16(v0[0], v0[1]); w.y = cvt_pk_bf16(v0[2], v0[3]); w.z = cvt_pk_bf16(v1[0], v1[1]); w.w = cvt_pk_bf16(v1[2], v1[3]);
                    *(u32x4*)(rowp + bj * HALF) = w; } }
    }
};
template <bool RS> struct EpiSigmoid {
    static constexpr bool PERM = true, AFTER_DRAIN = false;
    bf16_t* O; int ldc; const float* SS;
    static __device__ __forceinline__ float sg(float x) { return __builtin_amdgcn_rcpf(1.0f + __builtin_amdgcn_exp2f(-1.4426950408889634f * x)); }
    __device__ __forceinline__ void operator()(const f32x4 (&acc)[2][2][4][2], const Unit& u, int wr, int wc, int fr, int fq) const {
        const int row0 = u.pm * BM + wr * 64 + fr; const int col0 = u.pn * BM + wc * 32 + 8 * fq;
        float rsv[2][4];
#pragma unroll
        for (int ai = 0; ai < 2; ++ai)
#pragma unroll
            for (int m = 0; m < 4; ++m) rsv[ai][m] = RS ? rs_of(SS, row0 + ai * HALF + m * 16) : 1.0f;
#pragma unroll
        for (int ai = 0; ai < 2; ++ai)
#pragma unroll
            for (int m = 0; m < 4; ++m) { bf16_t* rowp = O + (size_t)(row0 + ai * HALF + m * 16) * ldc + col0;
                const float rs = rsv[ai][m];
#pragma unroll
                for (int bj = 0; bj < 2; ++bj) { f32x4 v0 = acc[ai][bj][m][0], v1 = acc[ai][bj][m][1];
                    if (RS) { v0 = v0 * rs; v1 = v1 * rs; }
                    u32x4 w; w.x = cvt_pk_bf16(sg(v0[0]), sg(v0[1])); w.y = cvt_pk_bf16(sg(v0[2]), sg(v0[3])); w.z = cvt_pk_bf16(sg(v1[0]), sg(v1[1])); w.w = cvt_pk_bf16(sg(v1[2]), sg(v1[3]));
                    *(u32x4*)(rowp + bj * HALF) = w; } }
    }
};
template <bool RS> struct EpiSwiGLU {
    static constexpr bool PERM = true, AFTER_DRAIN = false;
    bf16_t* O; int ldc; const float* SS;
    static __device__ __forceinline__ float sl(float g, float up) { return g * __builtin_amdgcn_rcpf(1.0f + __builtin_amdgcn_exp2f(-1.4426950408889634f * g)) * up; }
    __device__ __forceinline__ void operator()(const f32x4 (&acc)[2][2][4][2], const Unit& u, int wr, int wc, int fr, int fq) const {
        const int row0 = u.pm * BM + wr * 64 + fr; const int col0 = u.pn * HALF + wc * 32 + 8 * fq;
        float rsv[2][4];
#pragma unroll
        for (int ai = 0; ai < 2; ++ai)
#pragma unroll
            for (int m = 0; m < 4; ++m) rsv[ai][m] = RS ? rs_of(SS, row0 + ai * HALF + m * 16) : 1.0f;
#pragma unroll
        for (int ai = 0; ai < 2; ++ai)
#pragma unroll
            for (int m = 0; m < 4; ++m) { bf16_t* rowp = O + (size_t)(row0 + ai * HALF + m * 16) * ldc + col0;
                f32x4 g0 = acc[ai][0][m][0], g1 = acc[ai][0][m][1], u0 = acc[ai][1][m][0], u1 = acc[ai][1][m][1];
                if (RS) { const float rs = rsv[ai][m]; g0 = g0 * rs; g1 = g1 * rs; u0 = u0 * rs; u1 = u1 * rs; }
                u32x4 w; w.x = cvt_pk_bf16(sl(g0[0], u0[0]), sl(g0[1], u0[1])); w.y = cvt_pk_bf16(sl(g0[2], u0[2]), sl(g0[3], u0[3]));
                w.z = cvt_pk_bf16(sl(g1[0], u1[0]), sl(g1[1], u1[1])); w.w = cvt_pk_bf16(sl(g1[2], u1[2]), sl(g1[3], u1[3]));
                *(u32x4*)rowp = w; }
    }
};
struct EpiResAddB {
    static constexpr bool PERM = false, AFTER_DRAIN = false;
    bf16_t* HB; int ldc; float* SS;
    __device__ __forceinline__ void operator()(const f32x4 (&acc)[2][2][4][2], const Unit& u, int wr, int wc, int fr, int fq) const {
        const int row0 = u.pm * BM + wr * 64 + fr, col0 = u.pn * BM + wc * 32 + 4 * fq;
#pragma unroll
        for (int ai = 0; ai < 2; ++ai) {
            uint2 o[4][2][2];
#pragma unroll
            for (int m = 0; m < 4; ++m)
#pragma unroll
                for (int bj = 0; bj < 2; ++bj)
#pragma unroll
                    for (int n = 0; n < 2; ++n) o[m][bj][n] = *(const uint2*)(HB + (size_t)(row0 + ai * HALF + m * 16) * ldc + col0 + bj * HALF + n * 16);
#pragma unroll
            for (int m = 0; m < 4; ++m) { const size_t off = (size_t)(row0 + ai * HALF + m * 16) * ldc + col0; float ss = 0.f;
#pragma unroll
                for (int bj = 0; bj < 2; ++bj)
#pragma unroll
                    for (int n = 0; n < 2; ++n) { const uint2 ov = o[m][bj][n]; const f32x4 a = acc[ai][bj][m][n];
                        uint2 w; w.x = cvt_pk_bf16(__uint_as_float(ov.x << 16) + a[0], __uint_as_float(ov.x & 0xffff0000u) + a[1]);
                        w.y = cvt_pk_bf16(__uint_as_float(ov.y << 16) + a[2], __uint_as_float(ov.y & 0xffff0000u) + a[3]); *(uint2*)(HB + off + bj * HALF + n * 16) = w;
                        const float h0 = __uint_as_float(w.x << 16), h1 = __uint_as_float(w.x & 0xffff0000u), h2 = __uint_as_float(w.y << 16), h3 = __uint_as_float(w.y & 0xffff0000u);
                        ss += (h0 * h0 + h1 * h1) + (h2 * h2 + h3 * h3); }
                ss += __shfl_xor(ss, 16); ss += __shfl_xor(ss, 32); if (fq == 0) SS[(size_t)(row0 + ai * HALF + m * 16) * 32 + u.pn * 4 + wc] = ss; }
            asm volatile("" ::: "memory"); }
    }
};
struct EpiGateResB {
    static constexpr bool PERM = false, AFTER_DRAIN = false;
    bf16_t* HB; const bf16_t* G; int ldc; float* SS;
    __device__ __forceinline__ void operator()(const f32x4 (&acc)[2][2][4][2], const Unit& u, int wr, int wc, int fr, int fq) const {
        const int row0 = u.pm * BM + wr * 64 + fr, col0 = u.pn * BM + wc * 32 + 4 * fq;
#pragma unroll
        for (int ai = 0; ai < 2; ++ai) {
            uint2 o[4][2][2], gq[4][2][2];
#pragma unroll
            for (int m = 0; m < 4; ++m)
#pragma unroll
                for (int bj = 0; bj < 2; ++bj)
#pragma unroll
                    for (int n = 0; n < 2; ++n) { const size_t off = (size_t)(row0 + ai * HALF + m * 16) * ldc + col0 + bj * HALF + n * 16; o[m][bj][n] = *(const uint2*)(HB + off); gq[m][bj][n] = *(const uint2*)(G + off); }
#pragma unroll
            for (int m = 0; m < 4; ++m) { const size_t off = (size_t)(row0 + ai * HALF + m * 16) * ldc + col0; float ss = 0.f;
#pragma unroll
                for (int bj = 0; bj < 2; ++bj)
#pragma unroll
                    for (int n = 0; n < 2; ++n) { const uint2 ov = o[m][bj][n], gw = gq[m][bj][n]; const f32x4 a = acc[ai][bj][m][n];
                        uint2 w; w.x = cvt_pk_bf16(fmaf(a[0], __uint_as_float(gw.x << 16), __uint_as_float(ov.x << 16)), fmaf(a[1], __uint_as_float(gw.x & 0xffff0000u), __uint_as_float(ov.x & 0xffff0000u)));
                        w.y = cvt_pk_bf16(fmaf(a[2], __uint_as_float(gw.y << 16), __uint_as_float(ov.y << 16)), fmaf(a[3], __uint_as_float(gw.y & 0xffff0000u), __uint_as_float(ov.y & 0xffff0000u))); *(uint2*)(HB + off + bj * HALF + n * 16) = w;
                        const float h0 = __uint_as_float(w.x << 16), h1 = __uint_as_float(w.x & 0xffff0000u), h2 = __uint_as_float(w.y << 16), h3 = __uint_as_float(w.y & 0xffff0000u);
                        ss += (h0 * h0 + h1 * h1) + (h2 * h2 + h3 * h3); }
                ss += __shfl_xor(ss, 16); ss += __shfl_xor(ss, 32); if (fq == 0) SS[(size_t)(row0 + ai * HALF + m * 16) * 32 + u.pn * 4 + wc] = ss; }
            asm volatile("" ::: "memory"); }
    }
};
template <class Epi, class Sched, bool ALIGN_EPI = false, bool SP2 = false>
__device__ __forceinline__ void gemm_phase(PG8_LAS unsigned char* lds, const Gemm g, const Sched& S, const Epi& E) {
    int tid = threadIdx.x; asm volatile("" : "+v"(tid)); const int wid = __builtin_amdgcn_readfirstlane(tid >> 6), lane = tid & 63, wr = wid >> 2, wc = wid & 3, fr = lane & 15, fq = lane >> 4;
    const int K = g.K, nt = K / BK;
    unsigned voffA[2], voffB[2];
#pragma unroll
    for (int i = 0; i < 2; ++i) { int R, C; stage_rc(tid * 16 + i * 8192, R, C); const int Rb = Epi::PERM ? ((R & ~31) + perm32(R & 31)) : R;
        voffA[i] = (unsigned)(R * K + C) * 2u; voffB[i] = (unsigned)(Rb * K + C) * 2u; }
    const size_t kstep = (size_t)(BK * 2);
    const size_t hstep = (size_t)HALF * K * 2;
    const size_t tstep = 2 * hstep;
    const unsigned ldsw = (unsigned)wid * 1024u;
    const int aoff = lds_byte(wr * 64 + fr, fq * 8), boff = lds_byte(wc * 32 + fr, fq * 8);
#define PG8_SA(b, h) (((b) * 2 + (h)) * HTB)
#define PG8_SB(b, h) ((4 + (b) * 2 + (h)) * HTB)
#define PG8_STAGE(bufoff, gbase, voff) do { _Pragma("unroll") for (int _i = 0; _i < 2; ++_i) \
        __builtin_amdgcn_global_load_lds((const unsigned*)((const char*)(gbase) + (voff)[_i]), (PG8_LAS unsigned*)(lds + (bufoff) + ldsw + _i * 8192), 16, 0, 0); } while (0)
#define PG8_LDA(dst, b, h) do { _Pragma("unroll") for (int m = 0; m < 4; ++m) _Pragma("unroll") for (int k = 0; k < 2; ++k) dst[m][k] = *(const PG8_LAS bf16x8*)(lds + PG8_SA(b, h) + aoff + m * 2048 + k * 1024); } while (0)
#define PG8_LDB(dst, b, h) do { _Pragma("unroll") for (int n = 0; n < 2; ++n) _Pragma("unroll") for (int k = 0; k < 2; ++k) dst[n][k] = *(const PG8_LAS bf16x8*)(lds + PG8_SB(b, h) + boff + n * 2048 + k * 1024); } while (0)
#define PG8_MMA(ai, bj, At, Bt) do { __builtin_amdgcn_s_setprio(1); _Pragma("unroll") for (int m = 0; m < 4; ++m) _Pragma("unroll") for (int n = 0; n < 2; ++n) _Pragma("unroll") for (int k = 0; k < 2; ++k) \
        acc[ai][bj][m][n] = __builtin_amdgcn_mfma_f32_16x16x32_bf16(Bt[n][k], At[m][k], acc[ai][bj][m][n], 0, 0, 0); __builtin_amdgcn_s_setprio(0); } while (0)
#define PG8_WAIT_V(n) asm volatile("s_waitcnt vmcnt(" #n ")" ::: "memory")
#define PG8_WAIT_L(n) asm volatile("s_waitcnt lgkmcnt(" #n ")" ::: "memory")
#define PG8_BAR __builtin_amdgcn_s_barrier()
#define PG8_SCHED __builtin_amdgcn_sched_barrier(0)
    Unit cur, nxt; int ui = 0;
    if (!S.next(0, cur)) return;
    f32x4 acc[2][2][4][2];
#pragma unroll
    for (int a = 0; a < 2; ++a)
#pragma unroll
        for (int b = 0; b < 2; ++b)
#pragma unroll
            for (int m = 0; m < 4; ++m)
#pragma unroll
                for (int n = 0; n < 2; ++n) acc[a][b][m][n] = (f32x4){0.f, 0.f, 0.f, 0.f};
    bf16x8 At[4][2], B0[2][2], B1[2][2];
    const char* cA = (const char*)g.A + (size_t)cur.pm * tstep; const char* cB = (const char*)g.Bt + (size_t)cur.pn * tstep;
    S.a_ready(cur);
    if constexpr (SP2) {
        PG8_STAGE(PG8_SB(0, 0), cB, voffB); PG8_STAGE(PG8_SB(0, 1), cB + hstep, voffB); PG8_STAGE(PG8_SA(0, 0), cA, voffA); PG8_STAGE(PG8_SA(0, 1), cA + hstep, voffA);
        if (wr == 1) PG8_BAR;
        PG8_WAIT_V(2); PG8_BAR;
        PG8_STAGE(PG8_SB(1, 0), cB + kstep, voffB); PG8_STAGE(PG8_SA(1, 0), cA + kstep, voffA); PG8_STAGE(PG8_SB(1, 1), cB + hstep + kstep, voffB);
        PG8_WAIT_V(6); PG8_BAR;
    } else {
        PG8_STAGE(PG8_SB(0, 0), cB, voffB); PG8_STAGE(PG8_SA(0, 0), cA, voffA); PG8_STAGE(PG8_SB(0, 1), cB + hstep, voffB); PG8_STAGE(PG8_SA(0, 1), cA + hstep, voffA);
        if (wr == 1) PG8_BAR;
        PG8_WAIT_V(4); PG8_BAR;
        PG8_STAGE(PG8_SB(1, 0), cB + kstep, voffB); PG8_STAGE(PG8_SA(1, 0), cA + kstep, voffA); PG8_STAGE(PG8_SB(1, 1), cB + hstep + kstep, voffB);
        PG8_WAIT_V(6); PG8_BAR;
    }
    for (;;) {
        const bool has_next = S.next(ui + 1, nxt);
        const char* nA = has_next ? (const char*)g.A + (size_t)nxt.pm * tstep : cA; const char* nB = has_next ? (const char*)g.Bt + (size_t)nxt.pn * tstep : cB;
        for (int t = 0; t < nt; t += 2) {
            const bool last = (t == nt - 2);
            const char* a1 = cA + (size_t)(t + 1) * kstep;
            const char* a2 = last ? nA : cA + (size_t)(t + 2) * kstep; const char* b2 = last ? nB : cB + (size_t)(t + 2) * kstep;
            const char* a3 = a2 + kstep; const char* b3 = b2 + kstep;
            if (last && has_next) S.a_ready(nxt);
            if constexpr (SP2) {
            PG8_LDB(B0, 0, 0); PG8_LDB(B1, 0, 1); PG8_SCHED; PG8_LDA(At, 0, 0); PG8_STAGE(PG8_SA(1, 1), a1 + hstep, voffA);
            PG8_WAIT_V(8); PG8_WAIT_L(0); PG8_BAR; PG8_MMA(0, 0, At, B0); PG8_MMA(0, 1, At, B1); PG8_BAR; PG8_SCHED;
            PG8_LDA(At, 0, 1); PG8_STAGE(PG8_SB(0, 0), b2, voffB); PG8_STAGE(PG8_SB(0, 1), b2 + hstep, voffB); PG8_STAGE(PG8_SA(0, 0), a2, voffA);
            PG8_WAIT_V(8); PG8_WAIT_L(0); PG8_BAR; PG8_MMA(1, 0, At, B0); PG8_MMA(1, 1, At, B1); PG8_BAR; PG8_SCHED;
            PG8_LDB(B0, 1, 0); PG8_LDB(B1, 1, 1); PG8_SCHED; PG8_LDA(At, 1, 0); PG8_STAGE(PG8_SA(0, 1), a2 + hstep, voffA);
            PG8_WAIT_V(8); PG8_WAIT_L(0); PG8_BAR; PG8_MMA(0, 0, At, B0); PG8_MMA(0, 1, At, B1); PG8_BAR; PG8_SCHED;
            PG8_LDA(At, 1, 1); PG8_STAGE(PG8_SB(1, 0), b3, voffB); PG8_STAGE(PG8_SB(1, 1), b3 + hstep, voffB); PG8_STAGE(PG8_SA(1, 0), a3, voffA);
            PG8_WAIT_V(8); PG8_WAIT_L(0); PG8_BAR; PG8_MMA(1, 0, At, B0); PG8_MMA(1, 1, At, B1); PG8_BAR; PG8_SCHED;
            } else {
            PG8_LDB(B0, 0, 0); PG8_SCHED; PG8_LDA(At, 0, 0); PG8_STAGE(PG8_SA(1, 1), a1 + hstep, voffA);
            PG8_WAIT_L(8); PG8_BAR; PG8_WAIT_L(0); PG8_MMA(0, 0, At, B0); PG8_BAR; PG8_SCHED;
            PG8_LDB(B1, 0, 1); PG8_STAGE(PG8_SB(0, 0), b2, voffB);
            PG8_BAR; PG8_WAIT_L(0); PG8_MMA(0, 1, At, B1); PG8_BAR;
            PG8_LDA(At, 0, 1); PG8_STAGE(PG8_SA(0, 0), a2, voffA);
            PG8_BAR; PG8_WAIT_L(0); PG8_MMA(1, 0, At, B0); PG8_BAR; PG8_SCHED;
            PG8_STAGE(PG8_SB(0, 1), b2 + hstep, voffB);
            PG8_WAIT_V(6); PG8_BAR; PG8_MMA(1, 1, At, B1); PG8_BAR;
            PG8_LDB(B0, 1, 0); PG8_SCHED; PG8_LDA(At, 1, 0); PG8_STAGE(PG8_SA(0, 1), a2 + hstep, voffA);
            PG8_WAIT_L(8); PG8_BAR; PG8_WAIT_L(0); PG8_MMA(0, 0, At, B0); PG8_BAR; PG8_SCHED;
            PG8_LDB(B1, 1, 1); PG8_STAGE(PG8_SB(1, 0), b3, voffB);
            PG8_BAR; PG8_WAIT_L(0); PG8_MMA(0, 1, At, B1); PG8_BAR;
            PG8_LDA(At, 1, 1); PG8_STAGE(PG8_SA(1, 0), a3, voffA);
            PG8_BAR; PG8_WAIT_L(0); PG8_MMA(1, 0, At, B0); PG8_BAR; PG8_SCHED;
            PG8_STAGE(PG8_SB(1, 1), b3 + hstep, voffB);
            PG8_WAIT_V(6); PG8_BAR; PG8_MMA(1, 1, At, B1); PG8_BAR;
            }
        }
        if constexpr (ALIGN_EPI) { if (wr == 0) PG8_BAR; }
        if constexpr (!Epi::AFTER_DRAIN) { E(acc, cur, wr, wc, fr, fq); S.done(cur); }
        if (!has_next) break;
#pragma unroll
        for (int a = 0; a < 2; ++a)
#pragma unroll
            for (int b = 0; b < 2; ++b)
#pragma unroll
                for (int m = 0; m < 4; ++m)
#pragma unroll
                    for (int n = 0; n < 2; ++n) acc[a][b][m][n] = (f32x4){0.f, 0.f, 0.f, 0.f};
        cur = nxt; cA = nA; cB = nB; ++ui;
        if constexpr (ALIGN_EPI) { if (wr == 1) PG8_BAR; }
    }
    PG8_WAIT_V(0);
    if constexpr (!ALIGN_EPI) { if (wr == 0) PG8_BAR; }
    PG8_BAR;
    if constexpr (Epi::AFTER_DRAIN) { E.fused(acc, cur, wr, wc, fr, fq, lds, wid, lane); S.done(cur); }
#undef PG8_SA
#undef PG8_SB
#undef PG8_STAGE
#undef PG8_LDA
#undef PG8_LDB
#undef PG8_MMA
#undef PG8_WAIT_V
#undef PG8_WAIT_L
#undef PG8_BAR
#undef PG8_SCHED
}
}
namespace att {
using bf16x8 = __attribute__((ext_vector_type(8))) short;
using s16x4  = __attribute__((ext_vector_type(4))) short;
using f32x16 = __attribute__((ext_vector_type(16))) float;
using u32x4  = __attribute__((ext_vector_type(4))) unsigned;
#define KSWZ(row, colB) ((row) * 256 + ((colB) ^ (((row) & 7) << 4)))
#define SBAR() __builtin_amdgcn_sched_barrier(0)
__device__ __forceinline__ int crow(int r, int hi) { return (r & 3) + 8 * (r >> 2) + 4 * hi; }
typedef float f32x2a_t __attribute__((ext_vector_type(2))); typedef __bf16 bf16x2a_t __attribute__((ext_vector_type(2)));
__device__ __forceinline__ unsigned cvtpk(float lo, float hi) { f32x2a_t v = {lo, hi}; bf16x2a_t b = __builtin_convertvector(v, bf16x2a_t); return __builtin_bit_cast(unsigned, b); }
__device__ __forceinline__ int v_st(int k, int c) { const int kk = (k & ~0xC) | ((k & 4) << 1) | ((k & 8) >> 1); return ((kk >> 3) * 4 + (c >> 5)) * 512 + ((kk & 7) * 32 + (c & 31)) * 2; }
__device__ __forceinline__ int v_rd_base(int lane) { return ((lane & 3) << 3) | (((lane >> 2) & 3) << 6) | (((lane >> 4) & 1) << 5) | (((lane >> 5) & 1) << 8); }
constexpr int v_rd_off(int d0, int ks, int half) { return d0 * 512 + ks * 4096 + half * 2048; }
template <int OFF> __device__ __forceinline__ s16x4 tr_read(int vb) {
  s16x4 r; asm volatile("ds_read_b64_tr_b16 %0, %1 offset:%2" : "=&v"(r) : "v"(vb), "i"(OFF) : "memory"); return r;
}
template <int D0> __device__ __forceinline__ void pv_one(f32x16& od, int vb, bf16x8 pa0, bf16x8 pa1, bf16x8 pa2, bf16x8 pa3) {
  const s16x4 l0 = tr_read<v_rd_off(D0, 0, 0)>(vb), h0 = tr_read<v_rd_off(D0, 0, 1)>(vb), l1 = tr_read<v_rd_off(D0, 1, 0)>(vb), h1 = tr_read<v_rd_off(D0, 1, 1)>(vb);
  const s16x4 l2 = tr_read<v_rd_off(D0, 2, 0)>(vb), h2 = tr_read<v_rd_off(D0, 2, 1)>(vb), l3 = tr_read<v_rd_off(D0, 3, 0)>(vb), h3 = tr_read<v_rd_off(D0, 3, 1)>(vb);
  asm volatile("s_waitcnt lgkmcnt(0)" ::: "memory"); SBAR();
#define PK(L, H) (bf16x8){L[0], L[1], L[2], L[3], H[0], H[1], H[2], H[3]}
  od = __builtin_amdgcn_mfma_f32_32x32x16_bf16(pa0, PK(l0, h0), od, 0, 0, 0);
  od = __builtin_amdgcn_mfma_f32_32x32x16_bf16(pa1, PK(l1, h1), od, 0, 0, 0);
  od = __builtin_amdgcn_mfma_f32_32x32x16_bf16(pa2, PK(l2, h2), od, 0, 0, 0);
  od = __builtin_amdgcn_mfma_f32_32x32x16_bf16(pa3, PK(l3, h3), od, 0, 0, 0);
#undef PK
}
template <int KS> __device__ __forceinline__ void pv_step(f32x16* o, int vb, bf16x8 pa) {
  const s16x4 l0 = tr_read<v_rd_off(0, KS, 0)>(vb), h0 = tr_read<v_rd_off(0, KS, 1)>(vb), l1 = tr_read<v_rd_off(1, KS, 0)>(vb), h1 = tr_read<v_rd_off(1, KS, 1)>(vb);
  const s16x4 l2 = tr_read<v_rd_off(2, KS, 0)>(vb), h2 = tr_read<v_rd_off(2, KS, 1)>(vb), l3 = tr_read<v_rd_off(3, KS, 0)>(vb), h3 = tr_read<v_rd_off(3, KS, 1)>(vb);
  asm volatile("s_waitcnt lgkmcnt(0)" ::: "memory"); SBAR();
#define PK(L, H) (bf16x8){L[0], L[1], L[2], L[3], H[0], H[1], H[2], H[3]}
  o[0] = __builtin_amdgcn_mfma_f32_32x32x16_bf16(pa, PK(l0, h0), o[0], 0, 0, 0);
  o[1] = __builtin_amdgcn_mfma_f32_32x32x16_bf16(pa, PK(l1, h1), o[1], 0, 0, 0);
  o[2] = __builtin_amdgcn_mfma_f32_32x32x16_bf16(pa, PK(l2, h2), o[2], 0, 0, 0);
  o[3] = __builtin_amdgcn_mfma_f32_32x32x16_bf16(pa, PK(l3, h3), o[3], 0, 0, 0);
#undef PK
}
__device__ __forceinline__ void pv_d0(f32x16* o, int vb, bf16x8 pa0, bf16x8 pa1, bf16x8 pa2, bf16x8 pa3) {
  pv_step<0>(o, vb, pa0); pv_step<1>(o, vb, pa1); pv_step<2>(o, vb, pa2); pv_step<3>(o, vb, pa3);
}

typedef unsigned short bf16;
__device__ __forceinline__ unsigned short f2bf(float f) { unsigned u = __float_as_uint(f); return (unsigned short)((u + 0x7fffu + ((u >> 16) & 1u)) >> 16); }

template <bool DIFF>
__device__ __forceinline__ void qkt(f32x16& a, f32x16& b, const char* Ks, const char* Qs, int krow, int r32, int hi) {
  a = f32x16{}; b = f32x16{};
#pragma unroll
  for (int d = 0; d < 4; ++d) {
    const int cb0 = (d * 16 + hi * 8) * 2, cb1 = ((d + 4) * 16 + hi * 8) * 2;
    const bf16x8 k0 = *reinterpret_cast<const bf16x8*>(Ks + KSWZ(krow, cb0)), q0 = *reinterpret_cast<const bf16x8*>(Qs + KSWZ(r32, cb0));
    const bf16x8 k1 = *reinterpret_cast<const bf16x8*>(Ks + KSWZ(krow, cb1)), q1 = *reinterpret_cast<const bf16x8*>(Qs + KSWZ(r32, cb1));
    a = __builtin_amdgcn_mfma_f32_32x32x16_bf16(k0, q0, a, 0, 0, 0);
    b = __builtin_amdgcn_mfma_f32_32x32x16_bf16(k1, q1, b, 0, 0, 0); }
  if (!DIFF) {
#pragma unroll
    for (int r = 0; r < 16; ++r) a[r] += b[r]; }
}
__device__ __forceinline__ void stat_upd(const f32x16& p0, float& m, float& l, const float C, const float cb) {
  float mx = p0[0];
#pragma unroll
  for (int r = 1; r < 16; ++r) mx = fmaxf(mx, p0[r]);
  { auto rr = __builtin_amdgcn_permlane32_swap(__float_as_uint(mx), __float_as_uint(mx), false, false);
    mx = fmaxf(__uint_as_float(rr[0]), __uint_as_float(rr[1])); }
  mx += cb;
  const float mn = fmaxf(m, mx), alpha = __builtin_amdgcn_exp2f((m - mn) * C), mnC = (cb - mn) * C; float s = 0.f;
#pragma unroll
  for (int r = 0; r < 16; ++r) s += __builtin_amdgcn_exp2f(fmaf(p0[r], C, mnC));
  l = l * alpha + s; m = mn;
}
__device__ __forceinline__ int t5_bucket(int rel) {
  const int ret = rel > 0 ? 16 : 0; const int n = rel < 0 ? -rel : rel;
  const float nf = (float)(n > 1 ? n : 1);
  int large = 8 + (int)(logf(nf / 8.0f) / 2.7725887f * 8.0f); large = large < 15 ? large : 15;
  return ret + (n < 8 ? n : large);
}

template <bool DIFF>
__device__ __forceinline__ void attn_unit(const bf16* __restrict__ Qb, const bf16* __restrict__ Kb, const bf16* __restrict__ Vb, bf16* __restrict__ Ob,
                                          const int t_lo, const int t_hi, const int q0, const int rows, const float lam, const float* __restrict__ tabg, const int head,
                                          const float* __restrict__ subg, char* lds) {
  int tid = threadIdx.x; asm volatile("" : "+v"(tid)); const int wid = tid >> 6, lane = tid & 63, r32 = lane & 31, hi = lane >> 5;
  char* K_lds = lds; char* V_lds = lds + 16384; float* tab = (float*)(lds + 32768);
  constexpr float SCALE = DIFF ? 0.125f : 0.08838834764831845f;
  constexpr float C = SCALE * 1.4426950408889634f;
  __syncthreads();
  if (DIFF) { for (int i = tid; i < 257; i += 512) tab[i] = tabg[t5_bucket(i - 128) * 8 + head] * 8.0f; }
  else      { for (int i = tid; i < 465; i += 512) tab[i] = tabg[head * 465 + i] * 11.313708498984761f; }
  char* Q_lds = lds + 36864 + wid * 8192;
  { const bf16* Qw = Qb + (size_t)(wid * 32 + r32) * 1024 + hi * 8;
#pragma unroll
    for (int d0 = 0; d0 < 8; ++d0) *reinterpret_cast<bf16x8*>(Q_lds + KSWZ(r32, (d0 * 16 + hi * 8) * 2)) = *reinterpret_cast<const bf16x8*>(Qw + d0 * 16); }
  const int sr = tid >> 4, sc = (tid & 15) * 8;
  const int vst0 = v_st(sr, sc), vst1 = v_st(32 + sr, sc), kst0 = KSWZ(sr, sc * 2), kst1 = KSWZ(32 + sr, sc * 2);
  const int vb0 = (int)(uintptr_t)V_lds + v_rd_base(lane);
  int rw = 0, rstart = 0;
  if (!DIFF) { rw = q0 + (wid >> 1); rstart = rw - 4; rstart = rstart < 0 ? 0 : rstart; rstart = rstart > rows - 8 ? rows - 8 : rstart; }
  const int qbase = q0 + wid * 32;
  float m1 = -1e30f, l1 = 0.f, m2 = -1e30f, l2 = 0.f;
  bf16x8 ks0, ks1, vs0, vs1;
#define KLOAD(t) do { const bf16* kp_ = Kb + (size_t)((t) * 64 + sr) * 1024 + sc; ks0 = *reinterpret_cast<const bf16x8*>(kp_); ks1 = *reinterpret_cast<const bf16x8*>(kp_ + 32 * 1024); } while (0)
#define VLOAD(t) do { const bf16* vp_ = Vb + (size_t)((t) * 64 + sr) * 1024 + sc; vs0 = *reinterpret_cast<const bf16x8*>(vp_); vs1 = *reinterpret_cast<const bf16x8*>(vp_ + 32 * 1024); } while (0)
#define KWRITE() do { *reinterpret_cast<bf16x8*>(K_lds + kst0) = ks0; *reinterpret_cast<bf16x8*>(K_lds + kst1) = ks1; } while (0)
#define VWRITE() do { *reinterpret_cast<bf16x8*>(V_lds + vst0) = vs0; *reinterpret_cast<bf16x8*>(V_lds + vst1) = vs1; } while (0)
#define BIAS_APPLY(t, hf, A_, B_, CB_) do { CB_ = 0.f; \
    if (DIFF) { const int k0_ = (t) * 64; \
      if (k0_ - (qbase + 31) >= 128) { CB_ = tab[256]; } \
      else if (k0_ + 63 - qbase <= -128) { CB_ = tab[0]; } \
      else { const int base_ = k0_ - (qbase + r32) + 128 + 4 * hi + 32 * (hf); \
        _Pragma("unroll") for (int r = 0; r < 16; ++r) { int i0_ = base_ + (r & 3) + 8 * (r >> 2); \
          i0_ = i0_ < 0 ? 0 : (i0_ > 256 ? 256 : i0_); \
          const float v0_ = tab[i0_]; A_[r] += v0_; B_[r] += v0_; } } \
    } else { const int dr_ = (t) - rw + 7; const int qc_ = 32 * (wid & 1) + r32; int cs_ = qc_ - 8; cs_ = cs_ < 0 ? 0 : (cs_ > 48 ? 48 : cs_); \
      _Pragma("unroll") for (int r = 0; r < 16; ++r) { const int kc0_ = crow(r, hi) + 32 * (hf); \
        const bool ok0_ = (kc0_ >= cs_) && (kc0_ < cs_ + 16); \
        const float v0_ = tab[ok0_ ? dr_ * 31 + (kc0_ - qc_ + 15) : 0]; \
        A_[r] = ok0_ ? A_[r] + v0_ : -1e30f; } } } while (0)

  if (DIFF) {
  KLOAD(t_lo);
  for (int t = t_lo; t < t_hi; ++t) {
    __syncthreads();
    KWRITE();
    __syncthreads();
    if (t + 1 < t_hi) KLOAD(t + 1);
    const bool active = DIFF || (t >= rstart && t < rstart + 8);
    if (active) {
      f32x16 a0, b0, a1, b1;
      qkt<DIFF>(a0, b0, K_lds, Q_lds, r32, r32, hi);
      qkt<DIFF>(a1, b1, K_lds, Q_lds, r32 + 32, r32, hi);
      SBAR();
      float cb0, cb1;
      BIAS_APPLY(t, 0, a0, b0, cb0);
      stat_upd(a0, m1, l1, C, cb0);
      if (DIFF) stat_upd(b0, m2, l2, C, cb0);
      SBAR();
      BIAS_APPLY(t, 1, a1, b1, cb1);
      stat_upd(a1, m1, l1, C, cb1);
      if (DIFF) stat_upd(b1, m2, l2, C, cb1);
    }
  }
  { auto rr = __builtin_amdgcn_permlane32_swap(__float_as_uint(l1), __float_as_uint(l1), false, false); l1 = __uint_as_float(rr[0]) + __uint_as_float(rr[1]); }
  }
  if (DIFF) { auto rr = __builtin_amdgcn_permlane32_swap(__float_as_uint(l2), __float_as_uint(l2), false, false); l2 = __uint_as_float(rr[0]) + __uint_as_float(rr[1]); }
  float* const wsc = (float*)(lds + 34816) + wid * 64;
  const float e1 = DIFF ? -m1 * C - __builtin_amdgcn_logf(l1) : 0.f, e2 = DIFF ? -m2 * C + __builtin_amdgcn_logf(fabsf(lam) / l2) : 0.f, nsg = lam < 0.f ? 1.f : -1.f;

  f32x16 o[4];
#pragma unroll
  for (int d = 0; d < 4; ++d) o[d] = f32x16{};
  KLOAD(t_lo); VLOAD(t_lo);
  for (int t = t_lo; t < t_hi; ++t) {
    __syncthreads();
    KWRITE(); VWRITE();
    __syncthreads();
    if (t + 1 < t_hi) { KLOAD(t + 1); VLOAD(t + 1); }
    const bool active = DIFF || (t >= rstart && t < rstart + 8);
    if (active) {
      bf16x8 pa0, pa1, pa2, pa3;
#define PK4(P, BASE, OUT) do { unsigned x0_ = cvtpk(P[BASE + 0], P[BASE + 1]), x1_ = cvtpk(P[BASE + 2], P[BASE + 3]);   \
    unsigned y0_ = cvtpk(P[BASE + 4], P[BASE + 5]), y1_ = cvtpk(P[BASE + 6], P[BASE + 7]);                              \
    auto r0_ = __builtin_amdgcn_permlane32_swap(x0_, y0_, false, false); auto r1_ = __builtin_amdgcn_permlane32_swap(x1_, y1_, false, false); \
    u32x4 w_ = {r0_[0], r1_[0], r0_[1], r1_[1]}; OUT = *reinterpret_cast<bf16x8*>(&w_); } while (0)
      f32x16 a0, b0, a1, b1;
      qkt<DIFF>(a0, b0, K_lds, Q_lds, r32, r32, hi);
      qkt<DIFF>(a1, b1, K_lds, Q_lds, r32 + 32, r32, hi);
      SBAR();
      float cb0, cb1;
      if (!DIFF) {
        BIAS_APPLY(t, 0, a0, b0, cb0); BIAS_APPLY(t, 1, a1, b1, cb1);
        float mx = a0[0];
#pragma unroll
        for (int r = 1; r < 16; ++r) mx = fmaxf(mx, a0[r]);
#pragma unroll
        for (int r = 0; r < 16; ++r) mx = fmaxf(mx, a1[r]);
        { auto rr = __builtin_amdgcn_permlane32_swap(__float_as_uint(mx), __float_as_uint(mx), false, false); mx = fmaxf(__uint_as_float(rr[0]), __uint_as_float(rr[1])); }
        const float mn = fmaxf(m1, mx), alpha = __builtin_amdgcn_exp2f((m1 - mn) * C), x1 = -mn * C; m1 = mn;
        float ps = 0.f;
#pragma unroll
        for (int r = 0; r < 16; ++r) { a0[r] = __builtin_amdgcn_exp2f(fmaf(a0[r], C, x1)); ps += a0[r]; }
#pragma unroll
        for (int r = 0; r < 16; ++r) { a1[r] = __builtin_amdgcn_exp2f(fmaf(a1[r], C, x1)); ps += a1[r]; }
        l1 = l1 * alpha + ps;
        if (__any(alpha < 1.0f)) {
          if (hi == 0) wsc[r32] = alpha;
          asm volatile("s_waitcnt lgkmcnt(0)" ::: "memory");
#pragma unroll
          for (int r = 0; r < 16; ++r) { const float al = wsc[crow(r, hi)];
#pragma unroll
            for (int d = 0; d < 4; ++d) o[d][r] *= al; }
        }
        PK4(a0, 0, pa0); PK4(a0, 8, pa1); PK4(a1, 0, pa2); PK4(a1, 8, pa3);
        SBAR();
        pv_step<0>(o, vb0, pa0); pv_step<1>(o, vb0, pa1); pv_step<2>(o, vb0, pa2); pv_step<3>(o, vb0, pa3);
      } else {
      BIAS_APPLY(t, 0, a0, b0, cb0);
      { const float x1 = fmaf(cb0, C, e1), x2 = fmaf(cb0, C, e2);
#pragma unroll
      for (int r = 0; r < 16; ++r) a0[r] = __builtin_amdgcn_exp2f(fmaf(a0[r], C, x1));
      if (DIFF) {
#pragma unroll
        for (int r = 0; r < 16; ++r) a0[r] = fmaf(nsg, __builtin_amdgcn_exp2f(fmaf(b0[r], C, x2)), a0[r]);
      } }
      PK4(a0, 0, pa0); PK4(a0, 8, pa1);
      SBAR();
      pv_step<0>(o, vb0, pa0); pv_step<1>(o, vb0, pa1);
      SBAR();
      BIAS_APPLY(t, 1, a1, b1, cb1);
      { const float x1 = fmaf(cb1, C, e1), x2 = fmaf(cb1, C, e2);
#pragma unroll
      for (int r = 0; r < 16; ++r) a1[r] = __builtin_amdgcn_exp2f(fmaf(a1[r], C, x1));
      if (DIFF) {
#pragma unroll
        for (int r = 0; r < 16; ++r) a1[r] = fmaf(nsg, __builtin_amdgcn_exp2f(fmaf(b1[r], C, x2)), a1[r]);
      } }
      PK4(a1, 0, pa2); PK4(a1, 8, pa3);
      SBAR();
      pv_step<2>(o, vb0, pa2); pv_step<3>(o, vb0, pa3);
      }
#undef PK4

    }
  }
  bf16* Ow = Ob + (size_t)(wid * 32) * 2048;
  if (DIFF) {
    float gsub[4];
#pragma unroll
    for (int d = 0; d < 4; ++d) gsub[d] = subg[32 * d + r32] * 0.8f;
#pragma unroll
    for (int r = 0; r < 16; ++r) {
      float ss = o[0][r] * o[0][r] + o[1][r] * o[1][r] + o[2][r] * o[2][r] + o[3][r] * o[3][r];
      ss += __shfl_xor(ss, 1); ss += __shfl_xor(ss, 2); ss += __shfl_xor(ss, 4); ss += __shfl_xor(ss, 8); ss += __shfl_xor(ss, 16);
      const float rs = 1.0f / sqrtf(ss * (1.0f / 128.0f) + 1e-6f);
      bf16* orow = Ow + (size_t)crow(r, hi) * 2048 + r32;
#pragma unroll
      for (int d = 0; d < 4; ++d) orow[32 * d] = f2bf(o[d][r] * rs * gsub[d]);
      asm volatile("" ::: "memory"); SBAR();
    }
  } else {
    { auto rr = __builtin_amdgcn_permlane32_swap(__float_as_uint(l1), __float_as_uint(l1), false, false); l1 = __uint_as_float(rr[0]) + __uint_as_float(rr[1]); }
    if (hi == 0) wsc[32 + r32] = l1;
    asm volatile("s_waitcnt lgkmcnt(0)" ::: "memory");
#pragma unroll
    for (int r = 0; r < 16; ++r) { bf16* orow = Ow + (size_t)crow(r, hi) * 2048 + r32; const float rl = 1.0f / wsc[32 + crow(r, hi)];
#pragma unroll
      for (int d = 0; d < 4; ++d) orow[32 * d] = f2bf(o[d][r] * rl);
      asm volatile("" ::: "memory"); SBAR(); }
  }
#undef KLOAD
#undef VLOAD
#undef KWRITE
#undef VWRITE
#undef BIAS_APPLY
}
}

typedef unsigned short bf16;
typedef float f32x4 __attribute__((ext_vector_type(4)));
typedef unsigned v4u __attribute__((ext_vector_type(4)));
typedef unsigned v2u __attribute__((ext_vector_type(2)));
typedef short s16x8 __attribute__((ext_vector_type(8)));
#define LAS __attribute__((address_space(3)))
constexpr int NWAVES = 8, NTHR = 512;
constexpr int T_TOK = 49152, TP = 16384, DM = 2048, DFF = 5632;
constexpr size_t MiB = 1u << 20;
constexpr size_t WS_HDN_P = 0, WS_HDN_S = 1 * MiB, WS_SS = 2 * MiB;
constexpr size_t WS_W_ABIN = 4 * MiB, WS_W_ABOUT = 28 * MiB, WS_W_CIN = 36 * MiB, WS_W_COUT = 60 * MiB;
constexpr size_t WS_W_FFIN = 68 * MiB, WS_W_FFOUT = 156 * MiB, WS_W_GATE = 200 * MiB, WS_W_PROJ = 216 * MiB;
constexpr size_t WS_XN = 218 * MiB, WS_Z = 410 * MiB, WS_SSP = 986 * MiB, WS_END = 1000 * MiB;
constexpr int LDS_BYTES = 147456;
constexpr size_t WS_BAR = 3 * MiB + 512 * 1024;
constexpr int LDS_BARST = LDS_BYTES - 64;
constexpr int N_PHASES = 23;

__device__ __forceinline__ unsigned f2bf(float f) { unsigned u = __float_as_uint(f); return (u + 0x7fffu + ((u >> 16) & 1u)) >> 16; }
__device__ __forceinline__ unsigned pk2(float lo, float hi) { return f2bf(lo) | (f2bf(hi) << 16); }
__device__ __forceinline__ float bfl(unsigned w) { return __uint_as_float(w << 16); }
__device__ __forceinline__ float bfh(unsigned w) { return __uint_as_float(w & 0xffff0000u); }
__device__ __forceinline__ float wave_sum(float v) {
#pragma unroll
  for (int o = 1; o < 64; o <<= 1) v += __shfl_xor(v, o);
  return v;
}
__device__ __forceinline__ int ltid() { int t = threadIdx.x; asm volatile("" : "+v"(t)); return t; }
__device__ __forceinline__ int lbid() { int t = blockIdx.x; asm volatile("" : "+s"(t)); return t; }
__device__ __forceinline__ int lgrid() { int t = gridDim.x; asm volatile("" : "+s"(t)); return t; }
struct Args { const float* in[29]; float* out; unsigned char* ws; int ph_lo, ph_hi; };

__device__ __forceinline__ void wt_item(const float* __restrict__ W, int K, int N, bf16* __restrict__ WT, bool ffmap, LAS float* scr, int item, int lane, const float* __restrict__ gain = nullptr) {
  const int nblk = N / 32, kb = item / nblk, nb = item % nblk, k0 = 64 * kb, n0 = 32 * nb;
  int d0 = n0;
  if (ffmap) { const int up = n0 >= DFF ? 1 : 0; const int j = n0 - up * DFF; d0 = 256 * (j >> 7) + 128 * up + (j & 127); }
  {
    const int cc = (lane & 7) * 4; f32x4 v[8]; float gk[8];
#pragma unroll
    for (int i = 0; i < 8; ++i) { const int kk = 8 * i + (lane >> 3); v[i] = *(const f32x4*)(W + (size_t)(k0 + kk) * N + n0 + cc); gk[i] = gain ? gain[k0 + kk] : 1.0f; }
#pragma unroll
    for (int i = 0; i < 8; ++i) { const int kk = 8 * i + (lane >> 3); LAS float* d = scr + kk * 33 + cc; d[0] = v[i][0] * gk[i]; d[1] = v[i][1] * gk[i]; d[2] = v[i][2] * gk[i]; d[3] = v[i][3] * gk[i]; }
  }
  asm volatile("s_waitcnt lgkmcnt(0)" ::: "memory");
  const int c = lane & 7;
#pragma unroll
  for (int j = 0; j < 4; ++j) { const int n = (lane >> 3) + 8 * j; const LAS float* s = scr + (8 * c) * 33 + n;
    v4u o; o.x = pk2(s[0 * 33], s[1 * 33]); o.y = pk2(s[2 * 33], s[3 * 33]); o.z = pk2(s[4 * 33], s[5 * 33]); o.w = pk2(s[6 * 33], s[7 * 33]);
    *(v4u*)(WT + (size_t)(d0 + n) * K + k0 + 8 * c) = o; }
  asm volatile("s_waitcnt lgkmcnt(0)" ::: "memory");
}

__device__ __forceinline__ void rows_in(const float* xin0, const float* xin1, bf16* __restrict__ HB, float* __restrict__ SSx, int gw, int NGW, int lane) {
  for (int m0 = gw * 2; m0 < T_TOK; m0 += NGW * 2) {
    const float* src = m0 < TP ? xin0 + (size_t)m0 * DM : xin1 + (size_t)(m0 - TP) * DM;
    f32x4 v[2][8];
#pragma unroll
    for (int q = 0; q < 2; ++q)
#pragma unroll
      for (int j = 0; j < 8; ++j) v[q][j] = *(const f32x4*)(src + q * DM + 4 * (lane + 64 * j));
#pragma unroll
    for (int q = 0; q < 2; ++q) { float ss = 0.f;
#pragma unroll
      for (int j = 0; j < 8; ++j) { v2u w; w.x = pk2(v[q][j][0], v[q][j][1]); w.y = pk2(v[q][j][2], v[q][j][3]);
        *(v2u*)(HB + (size_t)(m0 + q) * DM + 4 * (lane + 64 * j)) = w;
        const float h0 = bfl(w.x), h1 = bfh(w.x), h2 = bfl(w.y), h3 = bfh(w.y); ss += (h0 * h0 + h1 * h1) + (h2 * h2 + h3 * h3); }
      ss = wave_sum(ss);
      if (lane == 0) SSx[m0 + q] = 1.0f / sqrtf(ss * (1.0f / 2048.0f) + 1e-6f); }
  }
}
__device__ __forceinline__ void rows_out(const bf16* __restrict__ HB, const float* __restrict__ SSf, const float* __restrict__ g, float* __restrict__ out, int gw, int NGW, int lane) {
  f32x4 gv[8];
#pragma unroll
  for (int j = 0; j < 8; ++j) gv[j] = *(const f32x4*)(g + 4 * (lane + 64 * j));
  for (int m0 = gw * 2; m0 < T_TOK; m0 += NGW * 2) {
    v2u w[2][8]; float sp[2];
#pragma unroll
    for (int q = 0; q < 2; ++q) { sp[q] = lane < 32 ? SSf[(size_t)(m0 + q) * 32 + lane] : 0.f;
#pragma unroll
      for (int j = 0; j < 8; ++j) w[q][j] = *(const v2u*)(HB + (size_t)(m0 + q) * DM + 4 * (lane + 64 * j)); }
#pragma unroll
    for (int q = 0; q < 2; ++q) { const float rs = 1.0f / sqrtf(wave_sum(sp[q]) * (1.0f / 2048.0f) + 1e-6f);
#pragma unroll
      for (int j = 0; j < 8; ++j) { f32x4 y; y[0] = bfl(w[q][j].x) * rs * gv[j][0]; y[1] = bfh(w[q][j].x) * rs * gv[j][1]; y[2] = bfl(w[q][j].y) * rs * gv[j][2]; y[3] = bfh(w[q][j].y) * rs * gv[j][3];
        *(f32x4*)(out + (size_t)(m0 + q) * DM + 4 * (lane + 64 * j)) = y; } }
  }
}
__device__ __forceinline__ void rs_rows(const float* __restrict__ SSP, float* __restrict__ RSV, int gw, int NGW, int lane) {
  for (int m = gw; m < T_TOK; m += NGW) {
    float sp = lane < 32 ? SSP[(size_t)m * 32 + lane] : 0.f;
    sp = wave_sum(sp);
    if (lane == 0) RSV[m] = 1.0f / sqrtf(sp * (1.0f / 2048.0f) + 1e-6f);
  }
}

template <class Sched>
__device__ __forceinline__ void rs_panels(const Sched& S, const float* __restrict__ SSP, float* __restrict__ RSV, const int tid) {
  pg8::Unit u; int last = -1;
  for (int i = 0; S.next(i, u); ++i) {
    if (u.pm == last) continue;
    last = u.pm;
    const int row = u.pm * 256 + (tid >> 1);
    const f32x4* p = (const f32x4*)(SSP + (size_t)row * 32 + (tid & 1) * 16);
    const f32x4 a = p[0], b = p[1], c = p[2], d = p[3];
    float sum = (((a[0] + a[1]) + (a[2] + a[3])) + ((b[0] + b[1]) + (b[2] + b[3]))) + (((c[0] + c[1]) + (c[2] + c[3])) + ((d[0] + d[1]) + (d[2] + d[3])));
    sum += __shfl_xor(sum, 1);
    if ((tid & 1) == 0) RSV[row] = 1.0f / sqrtf(sum * (1.0f / 2048.0f) + 1e-6f);
  }
  asm volatile("s_waitcnt vmcnt(0)" ::: "memory");
  __syncthreads();
}

#define PIDX(e) ((e) + ((e) >> 4))
__device__ __forceinline__ float2 cmul(float2 a, float2 b) { return make_float2(a.x * b.x - a.y * b.y, a.x * b.y + a.y * b.x); }
__device__ __forceinline__ constexpr float c16(int j) { return j == 0 ? 1.f : j == 1 ? 0.92387953251f : j == 2 ? 0.70710678119f : j == 3 ? 0.38268343237f : j == 4 ? 0.f : j == 5 ? -0.38268343237f : j == 6 ? -0.70710678119f : -0.92387953251f; }
__device__ __forceinline__ constexpr float s16(int j) { return j == 0 ? 0.f : j == 1 ? 0.38268343237f : j == 2 ? 0.70710678119f : j == 3 ? 0.92387953251f : j == 4 ? 1.f : j == 5 ? 0.92387953251f : j == 6 ? 0.70710678119f : 0.38268343237f; }
template <int LR, bool INV>
__device__ __forceinline__ void fft_stages(float2 (&x)[1 << LR], const int r, const int s) {
  constexpr int R = 1 << LR;
#pragma unroll
  for (int st = 0; st < LR; ++st) {
    const int hl = INV ? (1 << st) : (R >> (st + 1));
    const float fb = (float)r * (0.5f / (float)(hl * s));
    const float2 wb = make_float2(__builtin_amdgcn_cosf(fb), INV ? __builtin_amdgcn_sinf(fb) : -__builtin_amdgcn_sinf(fb));
#pragma unroll
    for (int m = 0; m < R; ++m) {
      if (m & hl) continue;
      const int k = m & (hl - 1); const int j = k * (8 / hl);
      const float2 wc = make_float2(c16(j), INV ? s16(j) : -s16(j));
      const float2 tw = cmul(wb, wc);
      if (!INV) { const float2 p = x[m], q = x[m + hl]; x[m] = make_float2(p.x + q.x, p.y + q.y); x[m + hl] = cmul(make_float2(p.x - q.x, p.y - q.y), tw); }
      else { const float2 p = x[m], q = cmul(x[m + hl], tw); x[m] = make_float2(p.x + q.x, p.y + q.y); x[m + hl] = make_float2(p.x - q.x, p.y - q.y); }
    }
  }
}
template <int LR, bool INV>
__device__ __forceinline__ void fft_pass(float2* X, const int N, const int sl, const int tid) {
  constexpr int R = 1 << LR;
  const int s = 1 << sl;
  for (int g = tid; g < (N >> LR); g += NTHR) {
    const int r = g & (s - 1);
    const int i0 = ((g >> sl) << (sl + LR)) + r;
    float2 x[R];
#pragma unroll
    for (int m = 0; m < R; ++m) x[m] = X[PIDX(i0 + (m << sl))];
    fft_stages<LR, INV>(x, r, s);
#pragma unroll
    for (int m = 0; m < R; ++m) X[PIDX(i0 + (m << sl))] = x[m];
  }
  __syncthreads();
}
template <int LR>
__device__ __forceinline__ void fft_first(float2* X, const bf16* __restrict__ u0, const bf16* __restrict__ u1, const int tid) {
  constexpr int R = 1 << LR;
  float2 x[R];
#pragma unroll
  for (int m = 0; m < R / 2; ++m) x[m] = make_float2(bfl(u0[tid + 512 * m]), bfl(u1[tid + 512 * m]));
#pragma unroll
  for (int m = R / 2; m < R; ++m) x[m] = make_float2(0.f, 0.f);
  fft_stages<LR, false>(x, tid, 512);
#pragma unroll
  for (int m = 0; m < R; ++m) X[PIDX(tid + 512 * m)] = x[m];
  __syncthreads();
}
__device__ __forceinline__ void fft_mid(float2* X, const float2* Hb, const int N, const float invN, const int tid) {
  for (int g = tid; g < (N >> 3); g += NTHR) {
    const int i0 = g << 3; const int p0 = PIDX(i0);
    float2 x[8];
#pragma unroll
    for (int m = 0; m < 8; ++m) x[m] = X[p0 + m];
    fft_stages<3, false>(x, 0, 1);
#pragma unroll
    for (int m = 0; m < 8; ++m) { const float2 h = Hb[p0 + m]; const float2 v = x[m]; x[m] = make_float2((v.x * h.x - v.y * h.y) * invN, (v.x * h.y + v.y * h.x) * invN); }
    fft_stages<3, true>(x, 0, 1);
#pragma unroll
    for (int m = 0; m < 8; ++m) X[p0 + m] = x[m];
  }
  __syncthreads();
}
template <int LR>
__device__ __forceinline__ void fft_last(float2* X, bf16* __restrict__ u0, bf16* __restrict__ u1, const int tid) {
  constexpr int R = 1 << LR;
  float2 x[R];
#pragma unroll
  for (int m = 0; m < R; ++m) x[m] = X[PIDX(tid + 512 * m)];
  fft_stages<LR, true>(x, tid, 512);
#pragma unroll
  for (int m = 0; m < R / 2; ++m) { u0[tid + 512 * m] = (bf16)f2bf(x[m].x); u1[tid + 512 * m] = (bf16)f2bf(x[m].y); }
  __syncthreads();
}
__device__ __forceinline__ void fft_fwd(float2* X, int N, int tid) {
  if (N == 8192) { fft_pass<4, false>(X, N, 9, tid); } else { fft_pass<3, false>(X, N, 9, tid); }
  fft_pass<3, false>(X, N, 6, tid); fft_pass<3, false>(X, N, 3, tid); fft_pass<3, false>(X, N, 0, tid);
}
__device__ __forceinline__ void fft_inv(float2* X, int N, int tid) {
  fft_pass<3, true>(X, N, 0, tid); fft_pass<3, true>(X, N, 3, tid); fft_pass<3, true>(X, N, 6, tid);
  if (N == 8192) { fft_pass<4, true>(X, N, 9, tid); } else { fft_pass<3, true>(X, N, 9, tid); }
}

#define XB_TMO      128
#define XB_XCNT(j)  (256  + 64 * (j))
#define XB_XSUB(j)  (1280 + 64 * (j))
#define XB_XGEN(j)  (2304 + 64 * (j))
#define XB_TOP      3328
#define XB_TOPGEN   3392
#define XCD_BAR_WORDS 3456
#define XB_SPIN_CAP (1u << 18)

__device__ __forceinline__ unsigned xb_ld(unsigned* p)              { return __hip_atomic_load(p, __ATOMIC_RELAXED, __HIP_MEMORY_SCOPE_AGENT); }
__device__ __forceinline__ unsigned xb_add(unsigned* p, unsigned v) { return __hip_atomic_fetch_add(p, v, __ATOMIC_RELAXED, __HIP_MEMORY_SCOPE_AGENT); }
__device__ __forceinline__ unsigned xb_xcc_id() { return (unsigned)__builtin_amdgcn_s_getreg((3 << 11) | 20) & 0xFu; }
#define XB_SPIN(cond, bar) do { unsigned _sp = 0; while (cond) { __builtin_amdgcn_s_sleep(1); \
    if ((++_sp & 255u) == 0u) { if (xb_ld(&(bar)[XB_TMO])) break; if (_sp > XB_SPIN_CAP) { atomicAdd(&(bar)[XB_TMO], 1u); break; } } } } while (0)

struct XcdBarrier {
    unsigned* bar; unsigned x;
    volatile LAS unsigned* st;
};

__device__ __forceinline__ XcdBarrier xcd_barrier_post(unsigned* bar, volatile LAS unsigned* st) {
    XcdBarrier b; b.bar = bar; b.x = xb_xcc_id(); b.st = st;
    if (threadIdx.x == 0) (void)xb_add(&bar[XB_XCNT(b.x)], 1u);
    return b;
}
__device__ __forceinline__ void xcd_barrier_complete(unsigned* bar, unsigned x, unsigned& nloc, unsigned& nx) {
    const unsigned G = gridDim.x * gridDim.y * gridDim.z;
    unsigned sum, cnt, mine, sp = 0u;
    for (;;) {
        sum = 0u; cnt = 0u; mine = 0u;
#pragma unroll
        for (unsigned j = 0; j < 16; ++j) { const unsigned c = xb_ld(&bar[XB_XCNT(j)]); sum += c; cnt += (c > 0u) ? 1u : 0u; mine = (j == x) ? c : mine; }
        if (sum == G) break;
        __builtin_amdgcn_s_sleep(1);
        if ((++sp & 255u) == 0u) { if (xb_ld(&bar[XB_TMO])) break; if (sp > XB_SPIN_CAP) { atomicAdd(&bar[XB_TMO], 1u); break; } }
    }
    nloc = mine > 0u ? mine : 1u; nx = cnt > 0u ? cnt : 1u;
}

__device__ __forceinline__ void xcd_barrier(const XcdBarrier& b) {
    asm volatile("s_waitcnt vmcnt(0)" ::: "memory");
    __syncthreads();
    if (threadIdx.x == 0) {
        unsigned* bar = b.bar;
        __builtin_amdgcn_s_waitcnt(0);
        unsigned nloc = b.st[0], nx = b.st[1];
        if (nloc == 0u) { xcd_barrier_complete(bar, b.x, nloc, nx); b.st[0] = nloc; b.st[1] = nx; }
        const unsigned old = xb_add(&bar[XB_XSUB(b.x)], 1u);
        const unsigned gen = old / nloc;
        if (old + 1u == (gen + 1u) * nloc) {
            __builtin_amdgcn_fence(__ATOMIC_RELEASE, "agent");
            asm volatile("s_waitcnt vmcnt(0)" ::: "memory");
            const unsigned og = xb_add(&bar[XB_TOP], 1u);
            const unsigned tg = og / nx;
            if (og + 1u == (tg + 1u) * nx) xb_add(&bar[XB_TOPGEN], 1u);
            else XB_SPIN(xb_ld(&bar[XB_TOPGEN]) == tg, bar);
            __builtin_amdgcn_fence(__ATOMIC_ACQUIRE, "agent");
            xb_add(&bar[XB_XGEN(b.x)], 1u);
            asm volatile("s_waitcnt vmcnt(0)" ::: "memory");
        } else {
            XB_SPIN(xb_ld(&bar[XB_XGEN(b.x)]) == gen, bar);
            __builtin_amdgcn_fence(__ATOMIC_ACQUIRE, "agent");
            asm volatile("s_waitcnt vmcnt(0)" ::: "memory");
        }
    }
    __syncthreads();
}

#define CAS __attribute__((address_space(4)))
__device__ __forceinline__ const void* ldarg(int i) {
  CAS const char* kp = (CAS const char*)__builtin_amdgcn_kernarg_segment_ptr();
  asm volatile("" : "+s"(kp));
  typedef const void* cvp_t;
  const void* p = *(CAS const cvp_t*)(kp + 8 * i);
  return (const void*)(__attribute__((address_space(1))) const char*)p;
}
__device__ __forceinline__ int ldint(int off) {
  CAS const char* kp = (CAS const char*)__builtin_amdgcn_kernarg_segment_ptr();
  asm volatile("" : "+s"(kp));
  return *(CAS const int*)(kp + off);
}
#define AIN(i) ((const float*)ldarg(i))
#define AOUT ((float*)ldarg(29))
#define AWS ((unsigned char*)ldarg(30))
__global__ void __launch_bounds__(NTHR, 2) mega_fwd(Args a_unused) {
  extern __shared__ __attribute__((aligned(16))) unsigned char lds[];
  cg::grid_group grid = cg::this_grid();
#define tid ltid()
#define lane (ltid() & 63)
#define wave __builtin_amdgcn_readfirstlane(ltid() >> 6)
#define G lgrid()
#define bx lbid()
#ifdef ONLY_PHASE
#define IN(k) ((k) == ONLY_PHASE)
#else
#ifndef SKIP_MASK
#define SKIP_MASK 0u
#endif
#define IN(k) (ldint(248) <= (k) && (k) < ldint(252) && !((SKIP_MASK >> (k)) & 1u))
#endif
#define INR(k) (ldint(248) <= (k) && (k) < ldint(252))
#define SEAM(k) do { if (INR(k) && INR((k) + 1)) { if ((k) == 0) grid.sync(); else xcd_barrier(xbar); } } while (0)
#define GEMM_LDS ((LAS unsigned char*)lds)
#define ws AWS
#define XN ((bf16*)(ws + WS_XN))
#define Z ((bf16*)(ws + WS_Z))

  volatile LAS unsigned* barst = (volatile LAS unsigned*)((LAS unsigned char*)lds + LDS_BARST);
  if (ltid() < 2) barst[ltid()] = 0u;
  __syncthreads();
  XcdBarrier xbar; xbar.bar = (unsigned*)(ws + WS_BAR); xbar.x = 0; xbar.st = barst;
  if (IN(0)) {
    if (bx == 0) { unsigned* bw = (unsigned*)(ws + WS_BAR); for (int i = tid; i < XCD_BAR_WORDS; i += NTHR) bw[i] = 0u; }
    LAS float* scr = (LAS float*)((LAS unsigned char*)lds + wave * 16384);
    const int gw = bx * NWAVES + wave, NGW = G * NWAVES;
    constexpr int I_IN = 32 * 192, I_OUT = 32 * 64, I_FI = 32 * 352, I_FO = 88 * 64, I_PJ = 4 * 64;
    constexpr int NITEMS = 2 * I_IN + 2 * I_OUT + 2 * I_FI + 2 * I_FO + 2 * I_OUT + 2 * I_PJ;
    for (int it = gw; it < NITEMS; it += NGW) {
      int r = it;
      if (r < I_IN) { wt_item(AIN(9), 2048, 6144, (bf16*)(ws + WS_W_ABIN), false, scr, r, lane, AIN(5)); continue; } r -= I_IN;
      if (r < I_IN) { wt_item(AIN(14), 2048, 6144, (bf16*)(ws + WS_W_CIN), false, scr, r, lane, AIN(5) + 2048); continue; } r -= I_IN;
      if (r < I_OUT) { wt_item(AIN(10), 2048, 2048, (bf16*)(ws + WS_W_ABOUT), false, scr, r, lane); continue; } r -= I_OUT;
      if (r < I_OUT) { wt_item(AIN(24), 2048, 2048, (bf16*)(ws + WS_W_COUT), false, scr, r, lane); continue; } r -= I_OUT;
      if (r < 2 * I_FI) { const int l = r / I_FI; wt_item(AIN(25) + (size_t)l * 2048 * 11264, 2048, 11264, (bf16*)(ws + WS_W_FFIN) + (size_t)l * 11264 * 2048, true, scr, r % I_FI, lane, AIN(6) + l * 2048); continue; } r -= 2 * I_FI;
      if (r < 2 * I_FO) { const int l = r / I_FO; wt_item(AIN(26) + (size_t)l * 5632 * 2048, 5632, 2048, (bf16*)(ws + WS_W_FFOUT) + (size_t)l * 2048 * 5632, false, scr, r % I_FO, lane); continue; } r -= 2 * I_FO;
      if (r < 2 * I_OUT) { const int l = r / I_OUT; wt_item(AIN(28) + (size_t)l * 2048 * 2048, 2048, 2048, (bf16*)(ws + WS_W_GATE) + (size_t)l * 2048 * 2048, false, scr, r % I_OUT, lane, AIN(7) + l * 2048); continue; } r -= 2 * I_OUT;
      { const int l = r / I_PJ; wt_item(AIN(27) + (size_t)l * 256 * 2048, 256, 2048, (bf16*)(ws + WS_W_PROJ) + (size_t)l * 2048 * 256, false, scr, r % I_PJ, lane); }
    }
    rows_in(AIN(0), AIN(1), XN, (float*)(ws + WS_SS), gw, NGW, lane);
    for (int row = gw; row < 2048 + 4096; row += NGW) {
      const int gsel = row >= 2048 ? 1 : 0; const int L = gsel ? 4096 : 2048; const int t = row - (gsel ? 2048 : 0);
      float* hd = (float*)(ws + (gsel ? WS_HDN_S : WS_HDN_P));
      const float tl = (float)t / (float)(L - 1);
      const float wt = (6.2831855f * (float)t) / (float)L;
      float feat = 0.f;
      if (lane == 0) feat = tl;
      else if (lane <= 32) { const int k = (lane - 1) & 15; const float fk = 1e-4f + (float)k * ((15.0f - 1e-4f) / 15.0f); const float ang = wt * fk; feat = lane <= 16 ? cosf(ang) : -sinf(ang); }
      const float* w1 = AIN(17); const float* b1 = AIN(18); const float* fr = AIN(19); const float* w2 = AIN(20); const float* b2 = AIN(21);
      float acc = b1[lane];
      for (int i = 0; i < 33; ++i) acc += __shfl(feat, i) * w1[i * 64 + lane];
      const float h1 = sinf(fr[lane] * acc);
      float acc2 = b2[lane];
      for (int i = 0; i < 64; ++i) acc2 += __shfl(h1, i) * w2[i * 64 + lane];
      hd[(size_t)lane * L + t] = sinf(fr[64 + lane] * acc2);
    }
  }
  SEAM(0);
  if (INR(0) && INR(1)) xbar = xcd_barrier_post((unsigned*)(ws + WS_BAR), barst);

  if (IN(1)) {
    pg8::Gemm g{XN, (const bf16*)(ws + WS_W_ABIN), T_TOK, 6144, 2048}; pg8::StaticOrder S; S.init(T_TOK, 6144, G, bx);
    pg8::EpiSplit<true> E{Z, 1024, 1024, (size_t)T_TOK * 1024, (const float*)(ws + WS_SS)};
    pg8::gemm_phase<pg8::EpiSplit<true>, pg8::StaticOrder, true, true>(GEMM_LDS, g, S, E);
    {
      float* FT = (float*)((char*)AOUT + 192 * MiB);
      float* wsm = (float*)lds;
      const float* w3 = AIN(22); const float* skip = AIN(23);
#pragma unroll 1
      for (int it = bx; it < 3072; it += G) {
        int gsel, cb8, tb;
        if (it < 2048) { gsel = 1; cb8 = it >> 3; tb = it & 7; } else { gsel = 0; const int v = it - 2048; cb8 = v >> 2; tb = v & 3; }
        const int L = gsel ? 4096 : 2048, N = 2 * L, t = tb * NTHR + tid;
        const float* hd = (const float*)(ws + (gsel ? WS_HDN_S : WS_HDN_P));
        __syncthreads();
        for (int q = tid; q < 1024; q += NTHR) { const int j = q >> 6, i = q & 63; wsm[q] = w3[(size_t)i * 4096 + (j < 8 ? cb8 * 8 + j : 2048 + cb8 * 8 + (j - 8))]; }
        __syncthreads();
        float x[64];
#pragma unroll
        for (int i = 0; i < 64; ++i) x[i] = hd[(size_t)i * L + t];
        const float tl = (float)t / (float)(L - 1);
        float* FTg = FT + (gsel ? (size_t)0 : (size_t)2048 * 8192);
#pragma unroll 1
        for (int j = 0; j < 8; ++j) {
          const int c = cb8 * 8 + j; float hf = 0.f, hb = 0.f;
#pragma unroll
          for (int i = 0; i < 64; i += 4) { const f32x4 wf = *(const f32x4*)(wsm + j * 64 + i), wb = *(const f32x4*)(wsm + (8 + j) * 64 + i);
            hf = fmaf(x[i], wf[0], hf); hf = fmaf(x[i + 1], wf[1], hf); hf = fmaf(x[i + 2], wf[2], hf); hf = fmaf(x[i + 3], wf[3], hf);
            hb = fmaf(x[i], wb[0], hb); hb = fmaf(x[i + 1], wb[1], hb); hb = fmaf(x[i + 2], wb[2], hb); hb = fmaf(x[i + 3], wb[3], hb); }
          const float delta = fabsf(-15.350567f + (float)c * ((-3.0701134f + 15.350567f) / 2047.0f));
          const float dec = expf(-tl * delta);
          hf *= dec; hb *= dec;
          float* row = FTg + (size_t)c * N;
          if (t == 0) { hf += skip[c]; row[L] = 0.f; }
          row[t] = hf;
          if (t >= 1) row[N - t] = hb;
        }
      }
    }
  }
  SEAM(1);

  if (IN(2)) {
    const size_t ZS = (size_t)T_TOK * 1024;
    const bf16 *QA = Z, *KA = Z + ZS, *VA = Z + 2 * ZS, *QB = Z + 3 * ZS, *KB = Z + 4 * ZS, *VB = Z + 5 * ZS;
    bf16* O = (bf16*)AOUT;
    const int vcu = (G % 8 == 0) ? (bx % 8) * (G / 8) + bx / 8 : bx;
    float lam;
    { const float* lv = AIN(11); const float s1 = wave_sum(lv[lane] * lv[64 + lane]), s2 = wave_sum(lv[128 + lane] * lv[192 + lane]); lam = expf(s1) - expf(s2) + 0.2f; }
#ifndef NO_DIFF
#pragma unroll 1
    for (int u = vcu; u < 1536; u += G) {
      int s, h, qb, L;
      if (u < 1024) { qb = u & 15; const int bh = u >> 4; h = bh & 7; s = 8 + (bh >> 3); L = 4096; }
      else { const int v = u - 1024; qb = v & 7; const int bh = v >> 3; h = bh & 7; s = bh >> 3; L = 2048; }
      const size_t mbase = s < 8 ? (size_t)s * 2048 : (size_t)TP + (size_t)(s - 8) * 4096;
      att::attn_unit<true>(QA + (mbase + 256 * qb) * 1024 + 128 * h, KA + mbase * 1024 + 128 * h, VA + mbase * 1024 + 128 * h,
                           O + (mbase + 256 * qb) * 2048 + 128 * h, 0, L / 64, 256 * qb, 0, lam, AIN(4), h, AIN(12), (char*)lds);
    }
#endif
#ifndef NO_NA
#pragma unroll 1
    for (int v = vcu; v < 1536; v += G) {
      int s, h, rb, rows;
      if (v < 1024) { rb = v & 15; const int bh = v >> 4; h = bh & 7; s = 8 + (bh >> 3); rows = 64; }
      else { const int w = v - 1024; rb = w & 7; const int bh = w >> 3; h = bh & 7; s = bh >> 3; rows = 32; }
      const size_t mbase = s < 8 ? (size_t)s * 2048 : (size_t)TP + (size_t)(s - 8) * 4096;
      int tl = 4 * rb - 4; tl = tl < 0 ? 0 : (tl > rows - 8 ? rows - 8 : tl);
      int th = 4 * rb + 3 - 4; th = th < 0 ? 0 : (th > rows - 8 ? rows - 8 : th); th += 8;
      att::attn_unit<false>(QB + (mbase + 256 * rb) * 1024 + 128 * h, KB + mbase * 1024 + 128 * h, VB + mbase * 1024 + 128 * h,
                            O + (mbase + 256 * rb) * 2048 + 1024 + 128 * h, tl, th, 4 * rb, rows, 0.f, AIN(13), h, nullptr, (char*)lds);
    }
#endif
    __syncthreads();
  }
  SEAM(2);

#pragma unroll
  for (int layer = 0; layer < 2; ++layer) {
    const int pb = layer == 0 ? 3 : 15;
    if (layer == 1) {
      if (IN(11)) {
        pg8::Gemm g{XN, (const bf16*)(ws + WS_W_CIN), T_TOK, 6144, 2048}; pg8::StaticOrder S; S.init(T_TOK, 6144, G, bx);
        rs_panels(S, (const float*)(ws + WS_SSP) + (size_t)T_TOK * 32, (float*)(ws + WS_SS) + 3 * T_TOK, tid);
        pg8::EpiSplit<true> E{Z, 2048, 2048, (size_t)T_TOK * 2048, (const float*)(ws + WS_SS) + 3 * T_TOK};
        pg8::gemm_phase<pg8::EpiSplit<true>, pg8::StaticOrder, true, true>(GEMM_LDS, g, S, E);
      }
      SEAM(11);
      constexpr size_t ZS = (size_t)T_TOK * 2048;
      if (IN(12)) {
        bf16* ut = (bf16*)lds;
        const bf16* Z1 = Z + ZS; const bf16* Z2 = Z + 2 * ZS; bf16* UT = (bf16*)AOUT; const float* cw = AIN(15); const float* cb = AIN(16);
        for (int it = bx; it < 768 * 32; it += G) {
          const int ct = it & 31, tt = it >> 5;
          const int tok = tid >> 3, cgp = tid & 7, m = tt * 64 + tok, c = ct * 64 + cgp * 8;
          const int L = m < TP ? 2048 : 4096; const int pos = m < TP ? (m & 2047) : ((m - TP) & 4095);
          const bool hp = pos > 0, hn = pos < L - 1;
          const s16x8 zero = {0, 0, 0, 0, 0, 0, 0, 0};
          const s16x8 x1p = hp ? *(const s16x8*)(Z1 + (size_t)(m - 1) * 2048 + c) : zero, x1c = *(const s16x8*)(Z1 + (size_t)m * 2048 + c), x1n = hn ? *(const s16x8*)(Z1 + (size_t)(m + 1) * 2048 + c) : zero;
          const s16x8 vp = hp ? *(const s16x8*)(Z2 + (size_t)(m - 1) * 2048 + c) : zero, vc = *(const s16x8*)(Z2 + (size_t)m * 2048 + c), vn = hn ? *(const s16x8*)(Z2 + (size_t)(m + 1) * 2048 + c) : zero;
          __syncthreads();
          f32x4 wa[4][2], wv[4][2];
#pragma unroll
          for (int k = 0; k < 3; ++k)
#pragma unroll
            for (int q = 0; q < 2; ++q) { wa[k][q] = *(const f32x4*)(cw + k * 6144 + 2048 + c + 4 * q); wv[k][q] = *(const f32x4*)(cw + k * 6144 + 4096 + c + 4 * q); }
#pragma unroll
          for (int q = 0; q < 2; ++q) { wa[3][q] = *(const f32x4*)(cb + 2048 + c + 4 * q); wv[3][q] = *(const f32x4*)(cb + 4096 + c + 4 * q); }
#pragma unroll
          for (int e = 0; e < 8; ++e) {
            const float x1 = wa[0][e >> 2][e & 3] * bfl((unsigned short)x1p[e]) + wa[1][e >> 2][e & 3] * bfl((unsigned short)x1c[e]) + wa[2][e >> 2][e & 3] * bfl((unsigned short)x1n[e]) + wa[3][e >> 2][e & 3];
            const float vv = wv[0][e >> 2][e & 3] * bfl((unsigned short)vp[e]) + wv[1][e >> 2][e & 3] * bfl((unsigned short)vc[e]) + wv[2][e >> 2][e & 3] * bfl((unsigned short)vn[e]) + wv[3][e >> 2][e & 3];
            ut[(cgp * 8 + e) * 72 + tok] = (bf16)f2bf(vv * x1);
          }
          __syncthreads();
          { const int ch = tid >> 3, chunk = tid & 7;
            *(v4u*)(UT + (size_t)(ct * 64 + ch) * T_TOK + tt * 64 + chunk * 8) = *(const v4u*)(ut + ch * 72 + chunk * 8); }
        }
        __syncthreads();
      }
      SEAM(12);
      if (IN(13)) {
        float2* A = (float2*)lds; float2* Hb = (float2*)(lds + 69632); float* wsm = (float*)(lds + 139264); bf16* UT = (bf16*)AOUT;
        const float* w3 = AIN(22); const float* skip = AIN(23);
#pragma unroll 1
        for (int u = bx; u < 4096; u += G) {
          const int gsel = u < 2048 ? 1 : 0, c = u & 2047;
          const int L = gsel ? 4096 : 2048, N = 2 * L;
          const float* hd = (const float*)(ws + (gsel ? WS_HDN_S : WS_HDN_P));
          __syncthreads();
          { const float* frow = (const float*)((const char*)AOUT + 192 * MiB) + (gsel ? (size_t)c * 8192 : (size_t)2048 * 8192 + (size_t)c * 4096);
            for (int n = tid; n < N; n += NTHR) Hb[PIDX(n)] = make_float2(frow[n], 0.f); }
          __syncthreads();
          fft_fwd(Hb, N, tid);
          const float invN = 1.0f / (float)N;
          const size_t sbase = gsel ? (size_t)TP : 0;
          bf16* urow = UT + (size_t)c * T_TOK + sbase;
#pragma unroll 1
          for (int pr = 0; pr < 4; ++pr) {
            bf16* u0 = urow + (size_t)(2 * pr) * L; bf16* u1 = u0 + L;
            if (gsel) fft_first<4>(A, u0, u1, tid); else fft_first<3>(A, u0, u1, tid);
            fft_pass<3, false>(A, N, 6, tid); fft_pass<3, false>(A, N, 3, tid);
            fft_mid(A, Hb, N, invN, tid);
            fft_pass<3, true>(A, N, 3, tid); fft_pass<3, true>(A, N, 6, tid);
            if (gsel) fft_last<4>(A, u0, u1, tid); else fft_last<3>(A, u0, u1, tid);
          }
        }
        __syncthreads();
      }
      SEAM(13);
      if (IN(14)) {
        bf16* yt = (bf16*)lds; bf16* O = Z + ZS; const bf16* Z0 = Z; const bf16* UT = (const bf16*)AOUT; const float* cw = AIN(15); const float* cb = AIN(16);
        for (int it = bx; it < 768 * 32; it += G) {
          const int ct = it & 31, tt = it >> 5;
          __syncthreads();
          { const int ch = tid >> 3, chunk = tid & 7;
            *(v4u*)(yt + ch * 72 + chunk * 8) = *(const v4u*)(UT + (size_t)(ct * 64 + ch) * T_TOK + tt * 64 + chunk * 8); }
          const int tok = tid >> 3, cgp = tid & 7, m = tt * 64 + tok, c = ct * 64 + cgp * 8;
          const int L = m < TP ? 2048 : 4096; const int pos = m < TP ? (m & 2047) : ((m - TP) & 4095);
          const bool hp = pos > 0, hn = pos < L - 1;
          const s16x8 zero = {0, 0, 0, 0, 0, 0, 0, 0};
          const s16x8 xp = hp ? *(const s16x8*)(Z0 + (size_t)(m - 1) * 2048 + c) : zero, xc = *(const s16x8*)(Z0 + (size_t)m * 2048 + c), xn = hn ? *(const s16x8*)(Z0 + (size_t)(m + 1) * 2048 + c) : zero;
          __syncthreads();
          float o[8];
          f32x4 wx[4][2];
#pragma unroll
          for (int k = 0; k < 3; ++k)
#pragma unroll
            for (int q = 0; q < 2; ++q) wx[k][q] = *(const f32x4*)(cw + k * 6144 + c + 4 * q);
#pragma unroll
          for (int q = 0; q < 2; ++q) wx[3][q] = *(const f32x4*)(cb + c + 4 * q);
#pragma unroll
          for (int e = 0; e < 8; ++e) {
            const float x0 = wx[0][e >> 2][e & 3] * bfl((unsigned short)xp[e]) + wx[1][e >> 2][e & 3] * bfl((unsigned short)xc[e]) + wx[2][e >> 2][e & 3] * bfl((unsigned short)xn[e]) + wx[3][e >> 2][e & 3];
            o[e] = bfl(yt[(cgp * 8 + e) * 72 + tok]) * x0;
          }
          v4u w; w.x = pk2(o[0], o[1]); w.y = pk2(o[2], o[3]); w.z = pk2(o[4], o[5]); w.w = pk2(o[6], o[7]);
          *(v4u*)(O + (size_t)m * 2048 + c) = w;
        }
        __syncthreads();
      }
      SEAM(14);
    }
    float* const SSb = (float*)(ws + WS_SSP);
    constexpr size_t SSN = (size_t)T_TOK * 32;
    if (IN(pb)) {
      const bf16* Oin = layer == 0 ? (const bf16*)AOUT : Z + (size_t)T_TOK * 2048;
      pg8::Gemm g{Oin, (const bf16*)(ws + (layer == 0 ? WS_W_ABOUT : WS_W_COUT)), T_TOK, 2048, 2048}; pg8::StaticOrder S; S.init(T_TOK, 2048, G, bx);
      pg8::EpiResAddB E{XN, 2048, SSb + (layer == 0 ? 1 : 0) * SSN}; pg8::gemm_phase<pg8::EpiResAddB, pg8::StaticOrder, true, true>(GEMM_LDS, g, S, E);
    }
    SEAM(pb);
    float* const RSb = (float*)(ws + WS_SS);
    if (IN(pb + 2)) {
      pg8::Gemm g{XN, (const bf16*)(ws + WS_W_FFIN) + (size_t)layer * 11264 * 2048, T_TOK, 11264, 2048}; pg8::StaticOrder S; S.init(T_TOK, 11264, G, bx);
      rs_panels(S, SSb + (layer == 0 ? 1 : 0) * SSN, RSb + (layer == 0 ? 1 : 4) * T_TOK, tid);
      pg8::EpiSwiGLU<true> E{Z, DFF, RSb + (layer == 0 ? 1 : 4) * T_TOK}; pg8::gemm_phase<pg8::EpiSwiGLU<true>, pg8::StaticOrder, true, true>(GEMM_LDS, g, S, E);
    }
    SEAM(pb + 2);
    if (IN(pb + 3)) {
      pg8::Gemm g{Z, (const bf16*)(ws + WS_W_FFOUT) + (size_t)layer * 2048 * 5632, T_TOK, 2048, DFF}; pg8::StaticOrder S; S.init(T_TOK, 2048, G, bx);
      pg8::EpiResAddB E{XN, 2048, SSb + (layer == 0 ? 0 : 1) * SSN};
      pg8::gemm_phase<pg8::EpiResAddB, pg8::StaticOrder, true, true>(GEMM_LDS, g, S, E);
      bf16* Pb = Z + (size_t)T_TOK * DFF;
      const int gw = bx * NWAVES + wave, NGW = G * NWAVES;
      const float* pp = AIN(2) + (size_t)layer * TP * 256; const float* psm = AIN(3) + (size_t)layer * (T_TOK - TP) * 256;
      for (int m = gw; m < T_TOK; m += NGW) {
        const float* src = m < TP ? pp + (size_t)m * 256 : psm + (size_t)(m - TP) * 256;
        const f32x4 v = *(const f32x4*)(src + 4 * lane); v2u w; w.x = pk2(v[0], v[1]); w.y = pk2(v[2], v[3]);
        *(v2u*)(Pb + (size_t)m * 256 + 4 * lane) = w;
      }
    }
    SEAM(pb + 3);
    if (IN(pb + 5)) {
      pg8::Gemm g{XN, (const bf16*)(ws + WS_W_GATE) + (size_t)layer * 2048 * 2048, T_TOK, 2048, 2048}; pg8::StaticOrder S; S.init(T_TOK, 2048, G, bx);
      rs_panels(S, SSb + (layer == 0 ? 0 : 1) * SSN, RSb + (layer == 0 ? 2 : 5) * T_TOK, tid);
      pg8::EpiSigmoid<true> E{Z, 2048, RSb + (layer == 0 ? 2 : 5) * T_TOK};
      pg8::gemm_phase<pg8::EpiSigmoid<true>, pg8::StaticOrder, true, true>(GEMM_LDS, g, S, E);
    }
    SEAM(pb + 5);
    if (IN(pb + 6)) {
      const bf16* Pb = Z + (size_t)T_TOK * DFF; const bf16* Gt = Z;
      pg8::Gemm g{Pb, (const bf16*)(ws + WS_W_PROJ) + (size_t)layer * 2048 * 256, T_TOK, 2048, 256}; pg8::StaticOrder S; S.init(T_TOK, 2048, G, bx);
      pg8::EpiGateResB E{XN, Gt, 2048, SSb + (layer == 0 ? 1 : 0) * SSN}; pg8::gemm_phase<pg8::EpiGateResB, pg8::StaticOrder, true, true>(GEMM_LDS, g, S, E);
    }
    SEAM(pb + 6);
    if (layer == 1) { if (IN(pb + 7)) rows_out(XN, SSb, AIN(8), AOUT, bx * NWAVES + wave, G * NWAVES, lane); }
  }
#undef IN
#undef SEAM
#undef tid
#undef lane
#undef wave
#undef G
#undef bx
#undef ws
#undef XN
#undef Z
}

#ifndef MK_MULTI
#define MK_MULTI 0
#endif
extern "C" void kernel_launch(void* const* d_in, const int* in_sizes, int n_in, void* d_out, int out_size, void* d_ws, size_t ws_size, hipStream_t stream) {
  static int grid = 0;
  if (grid == 0) {
    if (n_in != 29 || out_size != T_TOK * DM || ws_size < WS_END) { fprintf(stderr, "kernel_launch: unexpected shapes n_in %d out %d ws %zu (need %zu)\n", n_in, out_size, ws_size, (size_t)WS_END); grid = -1; return; }
    int dev = 0, cus = 0, per_cu = 0;
    hipGetDevice(&dev); hipDeviceGetAttribute(&cus, hipDeviceAttributeMultiprocessorCount, dev);
    if (hipFuncSetAttribute((const void*)mega_fwd, hipFuncAttributeMaxDynamicSharedMemorySize, LDS_BYTES) != hipSuccess) { fprintf(stderr, "kernel_launch: hipFuncSetAttribute failed\n"); grid = -1; return; }
    hipOccupancyMaxActiveBlocksPerMultiprocessor(&per_cu, (const void*)mega_fwd, NTHR, LDS_BYTES);
    (void)hipGetLastError();
    if (per_cu < 1) per_cu = 1;
    grid = cus * 1;
    fprintf(stderr, "kernel_launch: cus %d per_cu %d grid %d\n", cus, per_cu, grid);
  }
  if (grid < 0) return;
  Args a{};
  for (int i = 0; i < 29; ++i) a.in[i] = (const float*)d_in[i];
  a.out = (float*)d_out; a.ws = (unsigned char*)d_ws;
#if MK_MULTI
  for (int p = 0; p < N_PHASES; ++p) { a.ph_lo = p; a.ph_hi = p + 1; hipLaunchKernelGGL(mega_fwd, dim3(grid), dim3(NTHR), LDS_BYTES, stream, a); }
#else
  a.ph_lo = 0; a.ph_hi = N_PHASES;
  void* kargs[] = {&a};
  hipError_t e = hipLaunchCooperativeKernel((const void*)mega_fwd, dim3(grid), dim3(NTHR), kargs, LDS_BYTES, stream);
  if (e != hipSuccess) fprintf(stderr, "kernel_launch: cooperative launch failed: %s (grid %d)\n", hipGetErrorString(e), grid);
#endif
}
```
